# Optimizing an MI355X kernel written in HIP

```python
import jax, jax.numpy as jnp
from jax import lax
import numpy as np


D_MODEL = 1024
BATCH = 2
SEQ = 16384
DEPTH = 4
DEC_BATCH = 2
DEC_SEQ = 8192
PAST_LEN = 128

GRID_W = 64
N_EVEN = (DEPTH + 1) // 2
N_ODD = DEPTH // 2
EPS = 1e-6
NEG = -1e30
A_WIDTH = D_MODEL // 2
A_HEADS = 4
A_DK = A_WIDTH // A_HEADS
CHUNK = 64
NA_WIDTH = D_MODEL // 2
NA_HEADS = 8
NA_HD = NA_WIDTH // NA_HEADS
NA_KR_MAX = 8
NA_KC = 16
NA_QB = 16
NA_BAND = 32
NA_NCB = GRID_W // NA_QB
EVEN_IN = 5 * A_WIDTH + 3 * NA_WIDTH
CONV_W = 3
D_FF = -(-8 * D_MODEL // (3 * 256)) * 256

kernel_name = 'hybrid_hgrn2_natten_shortconv_encoder'


def _rmsnorm(x, g):
    x32 = x.astype(jnp.float32)
    y = x32 * lax.rsqrt(jnp.mean(x32 * x32, axis=-1, keepdims=True) + EPS) * g.astype(jnp.float32)
    return y.astype(x.dtype)


def _hgrn2_direction(q, k, v, logf):
    bsz, h, t, dk = q.shape
    dv = v.shape[-1]
    nc = t // CHUNK

    def chunks(a):
        return jnp.moveaxis(a.reshape(bsz, h, nc, CHUNK, a.shape[-1]), 2, 0)

    causal = jnp.tril(jnp.ones((CHUNK, CHUNK), dtype=bool))[:, :, None]

    def step(state, inp):
        qc, kc, vc, lf = inp
        b = jnp.cumsum(lf, axis=2)
        o_inter = jnp.einsum('bhti,bhij->bhtj', qc * jnp.exp(b), state)
        rel = b[:, :, :, None, :] - b[:, :, None, :, :]
        decay = jnp.exp(jnp.where(causal, rel, NEG))
        scores = jnp.einsum('bhti,bhtsi,bhsi->bhts', qc, decay, kc)
        o = o_inter + jnp.einsum('bhts,bhsj->bhtj', scores, vc)
        b_last = b[:, :, -1:, :]
        state = (jnp.exp(b_last[:, :, 0, :, None]) * state
                 + jnp.einsum('bhsi,bhsj->bhij', kc * jnp.exp(b_last - b), vc))
        return state, o

    s0 = jnp.zeros((bsz, h, dk, dv), jnp.float32)
    _, o = lax.scan(step, s0, (chunks(q), chunks(k), chunks(v), chunks(logf)))
    return jnp.moveaxis(o, 0, 2).reshape(bsz, h, t, dv)


def _hgrn2_mixer(q_a, z_f, z_b, i_a, g_a, lb, o_gain):
    bsz, t, _ = q_a.shape

    def heads(a):
        return a.astype(jnp.float32).reshape(bsz, t, A_HEADS, A_DK).transpose(0, 2, 1, 3)

    qh = heads(jax.nn.silu(q_a))
    ih = heads(i_a)
    lb32 = lb.astype(jnp.float32)

    def gate(z, lbd):
        z = z.astype(jnp.float32)
        f = lbd + (1.0 - lbd) * jax.nn.sigmoid(z)
        k = (1.0 - lbd) * jax.nn.sigmoid(-z)
        return heads(k), heads(jnp.log(f))

    k_f, lf_f = gate(z_f, lb32[0])
    k_b, lf_b = gate(z_b, lb32[1])
    flip = lambda a: jnp.flip(a, axis=2)
    o = (_hgrn2_direction(qh, k_f, ih, lf_f)
         + flip(_hgrn2_direction(flip(qh), flip(k_b), flip(ih), flip(lf_b))))
    o = o * lax.rsqrt(jnp.mean(o * o, axis=-1, keepdims=True) + EPS)
    o = o.transpose(0, 2, 1, 3).reshape(bsz, t, A_WIDTH) * o_gain.astype(jnp.float32)
    return (o * jax.nn.silu(g_a.astype(jnp.float32))).astype(q_a.dtype)


def _neighbourhood_attention(q, k, v, rpb):
    bsz, t, h, hd = q.shape
    rows = t // GRID_W
    kr = min(NA_KR_MAX, rows)
    r = jnp.arange(rows)
    row_start = jnp.clip(r - kr // 2, 0, rows - kr)
    key_rows = row_start[:, None] + jnp.arange(kr)
    j = jnp.arange(NA_NCB)
    band_start = jnp.clip(j * NA_QB - NA_KC // 2, 0, GRID_W - NA_BAND)
    key_cols = band_start[:, None] + jnp.arange(NA_BAND)
    qcol = j[:, None] * NA_QB + jnp.arange(NA_QB)
    win_start = jnp.clip(qcol - NA_KC // 2, 0, GRID_W - NA_KC)
    col_mask = ((key_cols[:, None, :] >= win_start[..., None])
                & (key_cols[:, None, :] < win_start[..., None] + NA_KC))
    tok = key_rows[:, None, :, None] * GRID_W + key_cols[None, :, None, :]
    kg = k[:, tok]
    vg = v[:, tok]
    qb = q.reshape(bsz, rows, NA_NCB, NA_QB, h, hd)
    s = jnp.einsum('brjqhd,brjkwhd->bhrjqkw', qb, kg).astype(jnp.float32) * (hd ** -0.5)
    row_off = key_rows - r[:, None] + NA_KR_MAX - 1
    col_off = jnp.clip(key_cols[:, None, :] - qcol[..., None], -(NA_KC - 1), NA_KC - 1) + NA_KC - 1
    bias = rpb.astype(jnp.float32)[:, row_off[:, None, None, :, None], col_off[None, :, :, None, :]]
    s = s + bias[None]
    s = jnp.where(col_mask[:, :, None, :], s, NEG)
    p = jax.nn.softmax(s.reshape(s.shape[:5] + (kr * NA_BAND,)), axis=-1).reshape(s.shape)
    o = jnp.einsum('bhrjqkw,brjkwhd->brjqhd', p, vg.astype(jnp.float32))
    return o.reshape(bsz, t, h * hd).astype(q.dtype)


def _even_mixer(h, w_in, w_out, lb, o_gain, rpb):
    bsz, t, _ = h.shape
    proj = h @ w_in
    splits = [A_WIDTH * n for n in range(1, 6)] + [5 * A_WIDTH + NA_WIDTH, 5 * A_WIDTH + 2 * NA_WIDTH]
    q_a, z_f, z_b, i_a, g_a, q_n, k_n, v_n = jnp.split(proj, splits, axis=-1)
    out_a = _hgrn2_mixer(q_a, z_f, z_b, i_a, g_a, lb, o_gain)
    hs = lambda a: a.reshape(bsz, t, NA_HEADS, NA_HD)
    out_n = _neighbourhood_attention(hs(q_n), hs(k_n), hs(v_n), rpb)
    return jnp.concatenate([out_a, out_n], axis=-1) @ w_out


def _conv_mixer(h, w_in, conv_w, w_out):
    b_g, c_g, u = jnp.split(h @ w_in, 3, axis=-1)
    z = c_g * u
    t = z.shape[1]
    pad = CONV_W // 2
    zp = jnp.pad(z, ((0, 0), (pad, pad), (0, 0)))
    conv = sum(zp[:, tap:tap + t] * conv_w[tap] for tap in range(CONV_W))
    return (b_g * conv) @ w_out


def _swiglu(h, w_in, w_out):
    gate, up = jnp.split(h @ w_in, 2, axis=-1)
    return (jax.nn.silu(gate) * up) @ w_out


def _trunk(x, norm_mix, norm_ffn, norm_final, even_w_in, even_w_out, hgrn_lb_logits, hgrn_norm,
           na_rpb, conv_w_in, conv_w, conv_w_out, ffn_w_in, ffn_w_out):
    p = jax.nn.softmax(hgrn_lb_logits.astype(jnp.float32), axis=0)
    lbs = jnp.cumsum(p, axis=0) - p[0]
    for l in range(DEPTH):
        h = _rmsnorm(x, norm_mix[l])
        if l % 2 == 0:
            e = l // 2
            x = x + _even_mixer(h, even_w_in[e], even_w_out[e], lbs[e], hgrn_norm[e], na_rpb[e])
        else:
            o = l // 2
            x = x + _conv_mixer(h, conv_w_in[o], conv_w[o], conv_w_out[o])
        x = x + _swiglu(_rmsnorm(x, norm_ffn[l]), ffn_w_in[l], ffn_w_out[l])
    return _rmsnorm(x, norm_final)


def setup_inputs(seed: int = 0) -> dict:
    key = jax.random.key(seed)
    ks = jax.random.split(key, 15)
    nrm = lambda k, shape, s: jax.random.normal(k, shape, jnp.float32) * s
    return {
        'x_prompt': nrm(ks[0], (BATCH, SEQ, D_MODEL), 1.0),
        'x_sample': nrm(ks[1], (DEC_BATCH, DEC_SEQ, D_MODEL), 1.0),
        'norm_mix': 1.0 + nrm(ks[2], (DEPTH, D_MODEL), 0.02),
        'norm_ffn': 1.0 + nrm(ks[3], (DEPTH, D_MODEL), 0.02),
        'norm_final': 1.0 + nrm(ks[4], (D_MODEL,), 0.02),
        'even_w_in': nrm(ks[5], (N_EVEN, D_MODEL, EVEN_IN), D_MODEL ** -0.5),
        'even_w_out': nrm(ks[6], (N_EVEN, A_WIDTH + NA_WIDTH, D_MODEL), (A_WIDTH + NA_WIDTH) ** -0.5),
        'hgrn_lb_logits': nrm(ks[7], (N_EVEN, 2, A_WIDTH), 0.5),
        'hgrn_norm': 1.0 + nrm(ks[8], (N_EVEN, A_WIDTH), 0.02),
        'na_rpb': nrm(ks[9], (N_EVEN, NA_HEADS, 2 * NA_KR_MAX - 1, 2 * NA_KC - 1), 0.1),
        'conv_w_in': nrm(ks[10], (N_ODD, D_MODEL, 3 * D_MODEL), D_MODEL ** -0.5),
        'conv_w': nrm(ks[11], (N_ODD, CONV_W, D_MODEL), CONV_W ** -0.5),
        'conv_w_out': nrm(ks[12], (N_ODD, D_MODEL, D_MODEL), D_MODEL ** -0.5),
        'ffn_w_in': nrm(ks[13], (DEPTH, D_MODEL, 2 * D_FF), D_MODEL ** -0.5),
        'ffn_w_out': nrm(ks[14], (DEPTH, D_FF, D_MODEL), D_FF ** -0.5),
    }


def reference(x_prompt, x_sample, norm_mix, norm_ffn, norm_final, even_w_in, even_w_out,
              hgrn_lb_logits, hgrn_norm, na_rpb, conv_w_in, conv_w, conv_w_out, ffn_w_in, ffn_w_out):
    y_prompt = _trunk(x_prompt, norm_mix, norm_ffn, norm_final, even_w_in, even_w_out, hgrn_lb_logits,
                      hgrn_norm, na_rpb, conv_w_in, conv_w, conv_w_out, ffn_w_in, ffn_w_out)
    y_sample = _trunk(x_sample, norm_mix, norm_ffn, norm_final, even_w_in, even_w_out, hgrn_lb_logits,
                      hgrn_norm, na_rpb, conv_w_in, conv_w, conv_w_out, ffn_w_in, ffn_w_out)
    return (y_prompt, y_sample)
```

```cpp
#include <hip/hip_runtime.h>
#include <hip/hip_cooperative_groups.h>
#include <cstdio>
#include <cstdint>
namespace cg = cooperative_groups;
namespace pg8 {
#define PG8_LAS __attribute__((address_space(3)))
typedef unsigned short bf16_t;
typedef short bf16x8 __attribute__((ext_vector_type(8)));
typedef float f32x4 __attribute__((ext_vector_type(4)));
typedef unsigned u32x4 __attribute__((ext_vector_type(4)));
constexpr int BM = 256, BK = 64, HALF = 128, HTB = HALF * BK * 2  , STAGE_BYTES = 8 * HTB, NXCD = 8, WGM = 4;

__host__ __device__ __forceinline__ int lds_byte(int r, int c) { const int st = (r >> 4) * 2 + (c >> 5), rr = r & 15, cc = c & 31, ob = rr * 64 + cc * 2; return st * 1024 + (ob ^ (((ob >> 9) & 1) << 5)); }
__host__ __device__ __forceinline__ void stage_rc(int b, int& R, int& C) { const int st = b / 1024, sb = b % 1024, swz = sb ^ (((sb >> 9) & 1) << 5); R = (st >> 1) * 16 + swz / 64; C = (st & 1) * 32 + (swz % 64) / 2; }
__host__ __device__ __forceinline__ int perm32(int rho) { const int n = rho >> 4, i = rho & 15; return 8 * (i >> 2) + 4 * n + (i & 3); }

struct Unit { int pm, pn, idx; };
struct Gemm { const bf16_t* A; const bf16_t* Bt; int M, N, K; };

struct StaticOrder {
    int nM, nN, nwg, G, c;
    __host__ __device__ void init(int M, int N, int G_, int c_) { nM = M / BM; nN = N / BM; nwg = nM * nN; G = G_; c = c_; }
    __host__ __device__ bool next(int i, Unit& u) const {
        const long L = (long)i * G + c; if (L >= nwg) return false;
        int wgid = (int)L; { const int q = nwg / NXCD, r = nwg % NXCD, xcd = wgid % NXCD, off = wgid / NXCD; wgid = (xcd < r ? xcd * (q + 1) : r * (q + 1) + (xcd - r) * q) + off; }
        const int nig = WGM * nN, gid = wgid / nig, fm = gid * WGM, gsz = (nM - fm) < WGM ? (nM - fm) : WGM;
        u.pm = fm + ((wgid % nig) % gsz); u.pn = (wgid % nig) / gsz; u.idx = i; return true;
    }
    __device__ __forceinline__ void a_ready(const Unit&) const {}
    __device__ __forceinline__ void done(const Unit&) const {}
};

typedef __bf16 bf16x2_e __attribute__((ext_vector_type(2)));
typedef float f32x2_e __attribute__((ext_vector_type(2)));
__device__ __forceinline__ unsigned cvt_pk_bf16(float lo, float hi) { const f32x2_e v = {lo, hi}; return __builtin_bit_cast(unsigned, __builtin_convertvector(v, bf16x2_e)); }
__device__ __forceinline__ float row_rs(const float* SS, int row) {
    const f32x4* p = (const f32x4*)(SS + (size_t)row * 16);
    const f32x4 a = p[0], b = p[1], c = p[2], d = p[3];
    const float s = ((a[0] + a[1]) + (a[2] + a[3])) + ((b[0] + b[1]) + (b[2] + b[3])) + ((c[0] + c[1]) + (c[2] + c[3])) + ((d[0] + d[1]) + (d[2] + d[3]));
    return rsqrtf(s * (1.0f / 1024.0f) + 1e-6f);
}
__device__ __forceinline__ float silu_f(float v) { return v * __builtin_amdgcn_rcpf(1.0f + __builtin_amdgcn_exp2f(-1.44269504f * v)); }
struct EpiScale {
    static constexpr bool PERM = true, AFTER_DRAIN = false;
    bf16_t* O; int ldc; const PG8_LAS float* RS;
    __device__ __forceinline__ void operator()(const f32x4 (&acc)[2][2][4][2], const Unit& u, int wr, int wc, int fr, int fq) const {
        const int row0 = u.pm * BM + wr * 64 + fr, col0 = u.pn * BM + wc * 32 + 8 * fq;
#pragma unroll
        for (int ai = 0; ai < 2; ++ai)
#pragma unroll
            for (int m = 0; m < 4; ++m) { const int row = row0 + ai * HALF + m * 16; const float rs = RS[u.idx * BM + wr * 64 + fr + ai * HALF + m * 16]; bf16_t* rowp = O + (size_t)row * ldc + col0;
#pragma unroll
                for (int bj = 0; bj < 2; ++bj) { const f32x4 v0 = acc[ai][bj][m][0] * rs, v1 = acc[ai][bj][m][1] * rs;
                    u32x4 w; w.x = cvt_pk_bf16(v0[0], v0[1]); w.y = cvt_pk_bf16(v0[2], v0[3]); w.z = cvt_pk_bf16(v1[0], v1[1]); w.w = cvt_pk_bf16(v1[2], v1[3]);
                    *(u32x4*)(rowp + bj * HALF) = w; } }
    }
};

struct EpiEven {
    static constexpr bool PERM = true, AFTER_DRAIN = false;
    bf16_t* O; const PG8_LAS float* RS; const float* lbl; int e;
    __device__ __forceinline__ void operator()(const f32x4 (&acc)[2][2][4][2], const Unit& u, int wr, int wc, int fr, int fq) const {
        const int row0 = u.pm * BM + wr * 64 + fr, col0 = u.pn * BM + wc * 32 + 8 * fq;
        const int pn = u.pn; const int mode = (pn < 2 || pn == 8 || pn == 9) ? 1 : ((pn >= 2 && pn < 6) ? 2 : 0);
        float lb[2][8];
#pragma unroll
        for (int bj = 0; bj < 2; ++bj)
#pragma unroll
            for (int x = 0; x < 8; ++x) lb[bj][x] = 0.f;
        if (mode == 2 && e == 1) { const int dir = pn >= 4, c0 = col0 - 512 - 512 * dir;
#pragma unroll
            for (int bj = 0; bj < 2; ++bj)
#pragma unroll
                for (int x = 0; x < 8; ++x) { const float l0 = lbl[dir * 512 + c0 + bj * HALF + x], l1 = lbl[(2 + dir) * 512 + c0 + bj * HALF + x]; lb[bj][x] = 1.0f / (1.0f + __expf(l0 - l1)); } }
#pragma unroll
        for (int ai = 0; ai < 2; ++ai)
#pragma unroll
            for (int m = 0; m < 4; ++m) { const int row = row0 + ai * HALF + m * 16; const float rs = RS[u.idx * BM + wr * 64 + fr + ai * HALF + m * 16]; bf16_t* rowp = O + (size_t)row * 4096 + col0;
#pragma unroll
                for (int bj = 0; bj < 2; ++bj) { float v[8];
#pragma unroll
                    for (int x = 0; x < 8; ++x) v[x] = acc[ai][bj][m][x >> 2][x & 3] * rs;
                    if (mode == 1) {
#pragma unroll
                        for (int x = 0; x < 8; ++x) v[x] = v[x] * __builtin_amdgcn_rcpf(1.0f + __builtin_amdgcn_exp2f(-1.44269504f * v[x]));
                    } else if (mode == 2) {
#pragma unroll
                        for (int x = 0; x < 8; ++x) { const float sg = __builtin_amdgcn_rcpf(1.0f + __builtin_amdgcn_exp2f(-1.44269504f * v[x])); v[x] = fmaxf(__builtin_amdgcn_logf(lb[bj][x] + (1.0f - lb[bj][x]) * sg), -115.f); }
                    }
                    u32x4 w; w.x = cvt_pk_bf16(v[0], v[1]); w.y = cvt_pk_bf16(v[2], v[3]); w.z = cvt_pk_bf16(v[4], v[5]); w.w = cvt_pk_bf16(v[6], v[7]);
                    *(u32x4*)(rowp + bj * HALF) = w; } }
    }
};
struct EpiSwiglu {
    static constexpr bool PERM = true, AFTER_DRAIN = false;
    bf16_t* H; int ldh; const PG8_LAS float* RS;
    __device__ __forceinline__ void operator()(const f32x4 (&acc)[2][2][4][2], const Unit& u, int wr, int wc, int fr, int fq) const {
        const int row0 = u.pm * BM + wr * 64 + fr, col0 = u.pn * HALF + wc * 32 + 8 * fq;
#pragma unroll
        for (int ai = 0; ai < 2; ++ai)
#pragma unroll
            for (int m = 0; m < 4; ++m) { const int row = row0 + ai * HALF + m * 16; const float rs = RS[u.idx * BM + wr * 64 + fr + ai * HALF + m * 16];
                const float c = -1.44269504f * rs, rs2 = rs * rs;
                f32x4 h[2];
#pragma unroll
                for (int n = 0; n < 2; ++n) {
                    const f32x4 g = acc[ai][0][m][n], up = acc[ai][1][m][n];
                    const f32x4 t = g * c; f32x4 d;
#pragma unroll
                    for (int x = 0; x < 4; ++x) d[x] = __builtin_amdgcn_exp2f(t[x]);
                    d = d + 1.0f;
#pragma unroll
                    for (int x = 0; x < 4; ++x) d[x] = __builtin_amdgcn_rcpf(d[x]);
                    h[n] = (g * up) * rs2 * d; }
                u32x4 w; w.x = cvt_pk_bf16(h[0][0], h[0][1]); w.y = cvt_pk_bf16(h[0][2], h[0][3]); w.z = cvt_pk_bf16(h[1][0], h[1][1]); w.w = cvt_pk_bf16(h[1][2], h[1][3]);
                *(u32x4*)(H + (size_t)row * ldh + col0) = w; }
    }
};
struct EpiConvIn {
    static constexpr bool PERM = true, AFTER_DRAIN = false;
    bf16_t* Bg; bf16_t* Z; const PG8_LAS float* RS;
    __device__ __forceinline__ void operator()(const f32x4 (&acc)[2][2][4][2], const Unit& u, int wr, int wc, int fr, int fq) const {
        const int row0 = u.pm * BM + wr * 64 + fr;
        if (u.pn < 4) {
            const int col0 = u.pn * BM + wc * 32 + 8 * fq;
#pragma unroll
            for (int ai = 0; ai < 2; ++ai)
#pragma unroll
                for (int m = 0; m < 4; ++m) { const int row = row0 + ai * HALF + m * 16; const float rs = RS[u.idx * BM + wr * 64 + fr + ai * HALF + m * 16]; bf16_t* rowp = Bg + (size_t)row * 1024 + col0;
#pragma unroll
                    for (int bj = 0; bj < 2; ++bj) { const f32x4 v0 = acc[ai][bj][m][0] * rs, v1 = acc[ai][bj][m][1] * rs;
                        u32x4 w; w.x = cvt_pk_bf16(v0[0], v0[1]); w.y = cvt_pk_bf16(v0[2], v0[3]); w.z = cvt_pk_bf16(v1[0], v1[1]); w.w = cvt_pk_bf16(v1[2], v1[3]);
                        *(u32x4*)(rowp + bj * HALF) = w; } }
        } else {
            const int col0 = (u.pn - 4) * HALF + wc * 32 + 8 * fq;
#pragma unroll
            for (int ai = 0; ai < 2; ++ai)
#pragma unroll
                for (int m = 0; m < 4; ++m) { const int row = row0 + ai * HALF + m * 16; const float rs = RS[u.idx * BM + wr * 64 + fr + ai * HALF + m * 16]; const float rs2 = rs * rs;
                    const f32x4 z0 = acc[ai][0][m][0] * acc[ai][1][m][0] * rs2, z1 = acc[ai][0][m][1] * acc[ai][1][m][1] * rs2;
                    u32x4 w; w.x = cvt_pk_bf16(z0[0], z0[1]); w.y = cvt_pk_bf16(z0[2], z0[3]); w.z = cvt_pk_bf16(z1[0], z1[1]); w.w = cvt_pk_bf16(z1[2], z1[3]);
                    *(u32x4*)(Z + (size_t)row * 1024 + col0) = w; }
        }
    }
};
__device__ __forceinline__ float bf_lo(unsigned w) { return __builtin_bit_cast(float, w << 16); }
__device__ __forceinline__ float bf_hi(unsigned w) { return __builtin_bit_cast(float, w & 0xffff0000u); }
struct EpiResid {
    static constexpr bool PERM = true, AFTER_DRAIN = false;
    const float* base32; const float* base32b; int split_pm; float* out32; bf16_t* XB; float* SS;
    __device__ __forceinline__ void operator()(const f32x4 (&acc)[2][2][4][2], const Unit& u, int wr, int wc, int fr, int fq) const {
        const int row0 = u.pm * BM + wr * 64 + fr, col0 = u.pn * BM + wc * 32 + 8 * fq;
        const float* const b32 = (u.pm < split_pm) ? base32 : base32b;
#pragma unroll
        for (int ai = 0; ai < 2; ++ai) {
            u32x4 xo[4][2];
            if (!base32) {
#pragma unroll
                for (int m = 0; m < 4; ++m)
#pragma unroll
                    for (int bj = 0; bj < 2; ++bj) xo[m][bj] = *(const u32x4*)(XB + (size_t)(row0 + ai * HALF + m * 16) * 1024 + col0 + bj * HALF);
            }
#pragma unroll
            for (int m = 0; m < 4; ++m) { const int row = row0 + ai * HALF + m * 16; const size_t off = (size_t)row * 1024 + col0; float ss = 0.f;
                f32x4 xf[2][2];
                if (base32) {
#pragma unroll
                    for (int bj = 0; bj < 2; ++bj) { xf[bj][0] = *(const f32x4*)(b32 + off + bj * HALF); xf[bj][1] = *(const f32x4*)(b32 + off + bj * HALF + 4); } }
#pragma unroll
                for (int bj = 0; bj < 2; ++bj) {
                    f32x4 x0, x1;
                    if (base32) { x0 = xf[bj][0]; x1 = xf[bj][1]; }
                    else { const u32x4 o = xo[m][bj]; x0 = (f32x4){bf_lo(o.x), bf_hi(o.x), bf_lo(o.y), bf_hi(o.y)}; x1 = (f32x4){bf_lo(o.z), bf_hi(o.z), bf_lo(o.w), bf_hi(o.w)}; }
                    x0 += acc[ai][bj][m][0]; x1 += acc[ai][bj][m][1];
                    if (out32) { *(f32x4*)(out32 + off + bj * HALF) = x0; *(f32x4*)(out32 + off + bj * HALF + 4) = x1; }
                    ss += (x0[0] * x0[0] + x0[1] * x0[1]) + (x0[2] * x0[2] + x0[3] * x0[3]) + (x1[0] * x1[0] + x1[1] * x1[1]) + (x1[2] * x1[2] + x1[3] * x1[3]);
                    u32x4 w; w.x = cvt_pk_bf16(x0[0], x0[1]); w.y = cvt_pk_bf16(x0[2], x0[3]); w.z = cvt_pk_bf16(x1[0], x1[1]); w.w = cvt_pk_bf16(x1[2], x1[3]);
                    *(u32x4*)(XB + off + bj * HALF) = w; }
                ss += __shfl_xor(ss, 16); ss += __shfl_xor(ss, 32);
                if (fq == 0) SS[(size_t)row * 16 + 4 * u.pn + wc] = ss; }
        }
    }
};
template <class Epi, class Sched, bool ALIGN_EPI = false, bool SP2 = false>
__device__ __forceinline__ void gemm_phase(PG8_LAS unsigned char* lds, const Gemm g, const Sched& S, const Epi& E) {
    int tid_ = threadIdx.x; asm volatile("" : "+v"(tid_)); const int tid = tid_, wid = __builtin_amdgcn_readfirstlane(tid >> 6), lane = tid & 63, wr = wid >> 2, wc = wid & 3, fr = lane & 15, fq = lane >> 4;
    const int K = g.K, nt = K / BK;
    unsigned voffA[2], voffB[2];
#pragma unroll
    for (int i = 0; i < 2; ++i) { int R, C; stage_rc(tid * 16 + i * 8192, R, C); const int Rb = Epi::PERM ? ((R & ~31) + perm32(R & 31)) : R;
        voffA[i] = (unsigned)(R * K + C) * 2u; voffB[i] = (unsigned)(Rb * K + C) * 2u; }
    const size_t kstep = (size_t)(BK * 2);
    const size_t hstep = (size_t)HALF * K * 2;
    const size_t tstep = 2 * hstep;
    const unsigned ldsw = (unsigned)wid * 1024u;
    const int aoff = lds_byte(wr * 64 + fr, fq * 8), boff = lds_byte(wc * 32 + fr, fq * 8);
#define PG8_SA(b, h) (((b) * 2 + (h)) * HTB)
#define PG8_SB(b, h) ((4 + (b) * 2 + (h)) * HTB)
#define PG8_STAGE(bufoff, gbase, voff) do { _Pragma("unroll") for (int _i = 0; _i < 2; ++_i) \
        __builtin_amdgcn_global_load_lds((const unsigned*)((const char*)(gbase) + (voff)[_i]), (PG8_LAS unsigned*)(lds + (bufoff) + ldsw + _i * 8192), 16, 0, 0); } while (0)
#define PG8_LDA(dst, b, h) do { _Pragma("unroll") for (int m = 0; m < 4; ++m) _Pragma("unroll") for (int k = 0; k < 2; ++k) dst[m][k] = *(const PG8_LAS bf16x8*)(lds + PG8_SA(b, h) + aoff + m * 2048 + k * 1024); } while (0)
#define PG8_LDB(dst, b, h) do { _Pragma("unroll") for (int n = 0; n < 2; ++n) _Pragma("unroll") for (int k = 0; k < 2; ++k) dst[n][k] = *(const PG8_LAS bf16x8*)(lds + PG8_SB(b, h) + boff + n * 2048 + k * 1024); } while (0)
#define PG8_MMA(ai, bj, At, Bt) do { __builtin_amdgcn_s_setprio(1); _Pragma("unroll") for (int m = 0; m < 4; ++m) _Pragma("unroll") for (int n = 0; n < 2; ++n) _Pragma("unroll") for (int k = 0; k < 2; ++k) \
        acc[ai][bj][m][n] = __builtin_amdgcn_mfma_f32_16x16x32_bf16(Bt[n][k], At[m][k], acc[ai][bj][m][n], 0, 0, 0); __builtin_amdgcn_s_setprio(0); } while (0)
#define PG8_WAIT_V(n) asm volatile("s_waitcnt vmcnt(" #n ")" ::: "memory")
#define PG8_WAIT_L(n) asm volatile("s_waitcnt lgkmcnt(" #n ")" ::: "memory")
#define PG8_BAR __builtin_amdgcn_s_barrier()
#define PG8_SCHED __builtin_amdgcn_sched_barrier(0)
    Unit cur, nxt; int ui = 0;
    if (!S.next(0, cur)) return;
    f32x4 acc[2][2][4][2];
#pragma unroll
    for (int a = 0; a < 2; ++a)
#pragma unroll
        for (int b = 0; b < 2; ++b)
#pragma unroll
            for (int m = 0; m < 4; ++m)
#pragma unroll
                for (int n = 0; n < 2; ++n) acc[a][b][m][n] = (f32x4){0.f, 0.f, 0.f, 0.f};
    bf16x8 At[4][2], B0[2][2], B1[2][2];
    const char* cA = (const char*)g.A + (size_t)cur.pm * tstep; const char* cB = (const char*)g.Bt + (size_t)cur.pn * tstep;
    S.a_ready(cur);
    if constexpr (SP2) {
        PG8_STAGE(PG8_SB(0, 0), cB, voffB); PG8_STAGE(PG8_SB(0, 1), cB + hstep, voffB); PG8_STAGE(PG8_SA(0, 0), cA, voffA); PG8_STAGE(PG8_SA(0, 1), cA + hstep, voffA);
        if (wr == 1) PG8_BAR;
        PG8_WAIT_V(2); PG8_BAR;
        PG8_STAGE(PG8_SB(1, 0), cB + kstep, voffB); PG8_STAGE(PG8_SA(1, 0), cA + kstep, voffA); PG8_STAGE(PG8_SB(1, 1), cB + hstep + kstep, voffB);
        PG8_WAIT_V(6); PG8_BAR;
    } else {
        PG8_STAGE(PG8_SB(0, 0), cB, voffB); PG8_STAGE(PG8_SA(0, 0), cA, voffA); PG8_STAGE(PG8_SB(0, 1), cB + hstep, voffB); PG8_STAGE(PG8_SA(0, 1), cA + hstep, voffA);
        if (wr == 1) PG8_BAR;
        PG8_WAIT_V(4); PG8_BAR;
        PG8_STAGE(PG8_SB(1, 0), cB + kstep, voffB); PG8_STAGE(PG8_SA(1, 0), cA + kstep, voffA); PG8_STAGE(PG8_SB(1, 1), cB + hstep + kstep, voffB);
        PG8_WAIT_V(6); PG8_BAR;
    }
    for (;;) {
        const bool has_next = S.next(ui + 1, nxt);
        const char* nA = has_next ? (const char*)g.A + (size_t)nxt.pm * tstep : cA; const char* nB = has_next ? (const char*)g.Bt + (size_t)nxt.pn * tstep : cB;
        for (int t = 0; t < nt; t += 2) {
            const bool last = (t == nt - 2);
            const char* a1 = cA + (size_t)(t + 1) * kstep;
            const char* a2 = last ? nA : cA + (size_t)(t + 2) * kstep; const char* b2 = last ? nB : cB + (size_t)(t + 2) * kstep;
            const char* a3 = a2 + kstep; const char* b3 = b2 + kstep;
            if (last && has_next) S.a_ready(nxt);
            if constexpr (SP2) {
            PG8_LDB(B0, 0, 0); PG8_LDB(B1, 0, 1); PG8_SCHED; PG8_LDA(At, 0, 0); PG8_STAGE(PG8_SA(1, 1), a1 + hstep, voffA);
            PG8_WAIT_V(8); PG8_WAIT_L(0); PG8_BAR; PG8_MMA(0, 0, At, B0); PG8_MMA(0, 1, At, B1); PG8_BAR; PG8_SCHED;
            PG8_LDA(At, 0, 1); PG8_STAGE(PG8_SB(0, 0), b2, voffB); PG8_STAGE(PG8_SB(0, 1), b2 + hstep, voffB); PG8_STAGE(PG8_SA(0, 0), a2, voffA);
            PG8_WAIT_V(8); PG8_WAIT_L(0); PG8_BAR; PG8_MMA(1, 0, At, B0); PG8_MMA(1, 1, At, B1); PG8_BAR; PG8_SCHED;
            PG8_LDB(B0, 1, 0); PG8_LDB(B1, 1, 1); PG8_SCHED; PG8_LDA(At, 1, 0); PG8_STAGE(PG8_SA(0, 1), a2 + hstep, voffA);
            PG8_WAIT_V(8); PG8_WAIT_L(0); PG8_BAR; PG8_MMA(0, 0, At, B0); PG8_MMA(0, 1, At, B1); PG8_BAR; PG8_SCHED;
            PG8_LDA(At, 1, 1); PG8_STAGE(PG8_SB(1, 0), b3, voffB); PG8_STAGE(PG8_SB(1, 1), b3 + hstep, voffB); PG8_STAGE(PG8_SA(1, 0), a3, voffA);
            PG8_WAIT_V(8); PG8_WAIT_L(0); PG8_BAR; PG8_MMA(1, 0, At, B0); PG8_MMA(1, 1, At, B1); PG8_BAR; PG8_SCHED;
            } else {
            PG8_LDB(B0, 0, 0); PG8_SCHED; PG8_LDA(At, 0, 0); PG8_STAGE(PG8_SA(1, 1), a1 + hstep, voffA);
            PG8_WAIT_L(8); PG8_BAR; PG8_WAIT_L(0); PG8_MMA(0, 0, At, B0); PG8_BAR; PG8_SCHED;
            PG8_LDB(B1, 0, 1); PG8_STAGE(PG8_SB(0, 0), b2, voffB);
            PG8_BAR; PG8_WAIT_L(0); PG8_MMA(0, 1, At, B1); PG8_BAR;
            PG8_LDA(At, 0, 1); PG8_STAGE(PG8_SA(0, 0), a2, voffA);
            PG8_BAR; PG8_WAIT_L(0); PG8_MMA(1, 0, At, B0); PG8_BAR; PG8_SCHED;
            PG8_STAGE(PG8_SB(0, 1), b2 + hstep, voffB);
            PG8_WAIT_V(6); PG8_BAR; PG8_MMA(1, 1, At, B1); PG8_BAR;
            PG8_LDB(B0, 1, 0); PG8_SCHED; PG8_LDA(At, 1, 0); PG8_STAGE(PG8_SA(0, 1), a2 + hstep, voffA);
            PG8_WAIT_L(8); PG8_BAR; PG8_WAIT_L(0); PG8_MMA(0, 0, At, B0); PG8_BAR; PG8_SCHED;
            PG8_LDB(B1, 1, 1); PG8_STAGE(PG8_SB(1, 0), b3, voffB);
            PG8_BAR; PG8_WAIT_L(0); PG8_MMA(0, 1, At, B1); PG8_BAR;
            PG8_LDA(At, 1, 1); PG8_STAGE(PG8_SA(1, 0), a3, voffA);
            PG8_BAR; PG8_WAIT_L(0); PG8_MMA(1, 0, At, B0); PG8_BAR; PG8_SCHED;
            PG8_STAGE(PG8_SB(1, 1), b3 + hstep, voffB);
            PG8_WAIT_V(6); PG8_BAR; PG8_MMA(1, 1, At, B1); PG8_BAR;
            }
        }
        if constexpr (ALIGN_EPI) { if (wr == 0) PG8_BAR; }
        if constexpr (!Epi::AFTER_DRAIN) { E(acc, cur, wr, wc, fr, fq); S.done(cur); }
        if (!has_next) break;
#pragma unroll
        for (int a = 0; a < 2; ++a)
#pragma unroll
            for (int b = 0; b < 2; ++b)
#pragma unroll
                for (int m = 0; m < 4; ++m)
#pragma unroll
                    for (int n = 0; n < 2; ++n) acc[a][b][m][n] = (f32x4){0.f, 0.f, 0.f, 0.f};
        cur = nxt; cA = nA; cB = nB; ++ui;
        if constexpr (ALIGN_EPI) { if (wr == 1) PG8_BAR; }
    }
    PG8_WAIT_V(0);
    if constexpr (!ALIGN_EPI) { if (wr == 0) PG8_BAR; }
    PG8_BAR;
    if constexpr (Epi::AFTER_DRAIN) { E.fused(acc, cur, wr, wc, fr, fq, lds, wid, lane); S.done(cur); }
#undef PG8_SA
#undef PG8_SB
#undef PG8_STAGE
#undef PG8_LDA
#undef PG8_LDB
#undef PG8_MMA
#undef PG8_WAIT_V
#undef PG8_WAIT_L
#undef PG8_BAR
#undef PG8_SCHED
}
}
#define LAS __attribute__((address_space(3)))
typedef unsigned short bf16;
typedef unsigned v4u __attribute__((ext_vector_type(4)));
typedef unsigned v2u __attribute__((ext_vector_type(2)));
typedef float f32x4 __attribute__((ext_vector_type(4)));
constexpr int NWAVES = 8, NTHR = 512;
constexpr int D = 1024, DFF = 2816, EIN = 4096, CIN = 3072, T_ALL = 49152;
constexpr int LDS_BYTES = 150528;
constexpr size_t MiB = 1u << 20;
constexpr size_t WS_WEIN = 1 * MiB;
constexpr size_t WS_WEOUT = WS_WEIN + 16 * MiB;
constexpr size_t WS_WCIN = WS_WEOUT + 4 * MiB;
constexpr size_t WS_WCOUT = WS_WCIN + 12 * MiB;
constexpr size_t WS_WFIN = WS_WCOUT + 4 * MiB;
constexpr size_t WS_WFOUT = WS_WFIN + 44 * MiB;
constexpr size_t WS_SS = WS_WFOUT + 22 * MiB;
constexpr size_t WS_DEC = WS_SS + 4 * MiB;
constexpr size_t WS_XB = WS_DEC + 2 * MiB;
constexpr size_t WS_END_A = WS_XB + (size_t)49152 * 1024 * 2 * 6, WS_END_B = WS_XB + (size_t)32768 * 1024 * 2 * 6;
static_assert(WS_END_A <= 768 * MiB && WS_END_B <= 512 * MiB, "ws map");

struct Params {
    const float *x_prompt, *x_sample, *norm_mix, *norm_ffn, *norm_final, *even_w_in, *even_w_out, *lb_logits, *hgrn_norm, *na_rpb, *conv_w_in, *conv_w, *conv_w_out, *ffn_w_in, *ffn_w_out;
    float* out; unsigned char* ws; int ph_lo, ph_hi, mode, pad;
};

typedef __bf16 bf16x2_t __attribute__((ext_vector_type(2)));
typedef float f32x2_t __attribute__((ext_vector_type(2)));
__device__ __forceinline__ unsigned pk2(float lo, float hi) { const f32x2_t v = {lo, hi}; return __builtin_bit_cast(unsigned, __builtin_convertvector(v, bf16x2_t)); }
__device__ __forceinline__ unsigned f2bf(float f) { return pk2(f, 0.f) & 0xffffu; }
__device__ __forceinline__ float bf2f(unsigned short b) { return __builtin_bit_cast(float, (unsigned)b << 16); }
__device__ __forceinline__ float bflo(unsigned w) { return __builtin_bit_cast(float, w << 16); }
__device__ __forceinline__ float bfhi(unsigned w) { return __builtin_bit_cast(float, w & 0xffff0000u); }
__device__ __forceinline__ float wave_sum(float v) {
#pragma unroll
    for (int o = 1; o < 64; o <<= 1) v += __shfl_xor(v, o);
    return v;
}

__device__ __forceinline__ int map_col(int type, int n) {
    if (type == 1) { return n < DFF ? 256 * (n >> 7) + (n & 127) : 256 * ((n - DFF) >> 7) + 128 + ((n - DFF) & 127); }
    if (type == 2) { if (n < 1024) return n; if (n < 2048) return 1024 + 256 * ((n - 1024) >> 7) + ((n - 1024) & 127); return 1024 + 256 * ((n - 2048) >> 7) + 128 + ((n - 2048) & 127); }
    return n;
}
__device__ __forceinline__ void transpose_item(const float* W, int K, int N, bf16* WT, int type, LAS float* scr, int item, int lane, const float* g = nullptr) {
    const int nblk = N / 32, kb = item / nblk, nb = item % nblk, k0 = 64 * kb, n0 = 32 * nb;
    float wv[32];
#pragma unroll
    for (int i = 0; i < 32; ++i) wv[i] = W[(size_t)(k0 + 2 * i + (lane >> 5)) * N + n0 + (lane & 31)];
    if (g) { float gv[32];
#pragma unroll
        for (int i = 0; i < 32; ++i) gv[i] = g[k0 + 2 * i + (lane >> 5)];
#pragma unroll
        for (int i = 0; i < 32; ++i) wv[i] *= gv[i]; }
#pragma unroll
    for (int i = 0; i < 32; ++i) scr[(2 * i + (lane >> 5)) * 33 + (lane & 31)] = wv[i];
    asm volatile("s_waitcnt lgkmcnt(0)" ::: "memory");
    const int c = lane & 7; const int r0 = map_col(type, n0);
#pragma unroll
    for (int j = 0; j < 4; ++j) { const int n = (lane >> 3) + 8 * j; const LAS float* s = scr + (8 * c) * 33 + n;
        v4u o; o.x = pk2(s[0 * 33], s[1 * 33]); o.y = pk2(s[2 * 33], s[3 * 33]); o.z = pk2(s[4 * 33], s[5 * 33]); o.w = pk2(s[6 * 33], s[7 * 33]);
        *(v4u*)(WT + (size_t)(r0 + n) * K + k0 + 8 * c) = o; }
    asm volatile("s_waitcnt lgkmcnt(0)" ::: "memory");
}
__device__ __forceinline__ void convert_weights(const Params& p, LAS unsigned char* lds, int wave, int lane) {
    LAS float* scr = (LAS float*)(lds + wave * 16384);
    const int gw = blockIdx.x * NWAVES + wave, NGW = gridDim.x * NWAVES;
    constexpr int I_EI = 16 * 128, I_EO = 16 * 32, I_CI = 16 * 96, I_CO = 16 * 32, I_FI = 16 * 176, I_FO = 44 * 32;
    constexpr int NITEMS = 2 * (I_EI + I_EO + I_CI + I_CO) + 4 * (I_FI + I_FO);
    bf16* ws = (bf16*)p.ws;
    for (int it = gw; it < NITEMS; it += NGW) {
        int r = it;
        if (r < 2 * I_EI) { const int e = r / I_EI; transpose_item(p.even_w_in + (size_t)e * D * EIN, D, EIN, (bf16*)(p.ws + WS_WEIN) + (size_t)e * EIN * D, 0, scr, r % I_EI, lane, p.norm_mix + (2 * e) * D); continue; } r -= 2 * I_EI;
        if (r < 2 * I_EO) { const int e = r / I_EO; transpose_item(p.even_w_out + (size_t)e * D * D, D, D, (bf16*)(p.ws + WS_WEOUT) + (size_t)e * D * D, 0, scr, r % I_EO, lane); continue; } r -= 2 * I_EO;
        if (r < 2 * I_CI) { const int e = r / I_CI; transpose_item(p.conv_w_in + (size_t)e * D * CIN, D, CIN, (bf16*)(p.ws + WS_WCIN) + (size_t)e * CIN * D, 2, scr, r % I_CI, lane, p.norm_mix + (2 * e + 1) * D); continue; } r -= 2 * I_CI;
        if (r < 2 * I_CO) { const int e = r / I_CO; transpose_item(p.conv_w_out + (size_t)e * D * D, D, D, (bf16*)(p.ws + WS_WCOUT) + (size_t)e * D * D, 0, scr, r % I_CO, lane); continue; } r -= 2 * I_CO;
        if (r < 4 * I_FI) { const int e = r / I_FI; transpose_item(p.ffn_w_in + (size_t)e * D * 2 * DFF, D, 2 * DFF, (bf16*)(p.ws + WS_WFIN) + (size_t)e * 2 * DFF * D, 1, scr, r % I_FI, lane, p.norm_ffn + e * D); continue; } r -= 4 * I_FI;
        { const int e = r / I_FO; transpose_item(p.ffn_w_out + (size_t)e * DFF * D, DFF, D, (bf16*)(p.ws + WS_WFOUT) + (size_t)e * D * DFF, 0, scr, r % I_FO, lane); }
    }
    (void)ws;
}
__device__ __forceinline__ void px_phase(const float* x, bf16* XB, float* SS, int M, int wave, int lane) {
    const int gw = blockIdx.x * NWAVES + wave, NGW = gridDim.x * NWAVES;
    for (int m0 = gw; m0 < M; m0 += 2 * NGW) {
        const int m1 = m0 + NGW; const bool two = m1 < M;
        const f32x4* xa = (const f32x4*)(x + (size_t)m0 * D) + lane; const f32x4* xb = (const f32x4*)(x + (size_t)(two ? m1 : m0) * D) + lane;
        f32x4 va[4], vb[4]; float sa = 0.f, sb = 0.f;
#pragma unroll
        for (int j = 0; j < 4; ++j) { va[j] = xa[64 * j]; vb[j] = xb[64 * j]; }
#pragma unroll
        for (int j = 0; j < 4; ++j) { sa += (va[j][0] * va[j][0] + va[j][1] * va[j][1]) + (va[j][2] * va[j][2] + va[j][3] * va[j][3]); sb += (vb[j][0] * vb[j][0] + vb[j][1] * vb[j][1]) + (vb[j][2] * vb[j][2] + vb[j][3] * vb[j][3]); }
        sa = wave_sum(sa); sb = wave_sum(sb);
        v2u* oa = (v2u*)(XB + (size_t)m0 * D) + lane;
#pragma unroll
        for (int j = 0; j < 4; ++j) { v2u w; w.x = pk2(va[j][0], va[j][1]); w.y = pk2(va[j][2], va[j][3]); oa[64 * j] = w; }
        if (lane < 16) SS[(size_t)m0 * 16 + lane] = (lane == 0) ? sa : 0.f;
        if (two) { v2u* ob = (v2u*)(XB + (size_t)m1 * D) + lane;
#pragma unroll
            for (int j = 0; j < 4; ++j) { v2u w; w.x = pk2(vb[j][0], vb[j][1]); w.y = pk2(vb[j][2], vb[j][3]); ob[64 * j] = w; }
            if (lane < 16) SS[(size_t)m1 * 16 + lane] = (lane == 0) ? sb : 0.f; }
    }
}
__device__ __forceinline__ void final_norm(const bf16* XB, float* out, const float* g, const float* SS, int M, int wave, int lane) {
    const int gw = blockIdx.x * NWAVES + wave, NGW = gridDim.x * NWAVES;
    f32x4 ga = ((const f32x4*)g)[2 * lane], gb = ((const f32x4*)g)[2 * lane + 1], gc = ((const f32x4*)g)[128 + 2 * lane], gd = ((const f32x4*)g)[128 + 2 * lane + 1];
    for (int m0 = gw; m0 < M; m0 += 2 * NGW) {
        const int m1 = m0 + NGW; const bool two = m1 < M; const int mb = two ? m1 : m0;
        const v4u* xa = (const v4u*)(XB + (size_t)m0 * D) + lane; const v4u* xb = (const v4u*)(XB + (size_t)mb * D) + lane;
        const v4u a0 = xa[0], a1 = xa[64], b0 = xb[0], b1 = xb[64];
        const float rsa = pg8::row_rs(SS, m0), rsb = pg8::row_rs(SS, mb);
        f32x4* oa = (f32x4*)(out + (size_t)m0 * D) + 2 * lane;
        oa[0] = (f32x4){bflo(a0.x), bfhi(a0.x), bflo(a0.y), bfhi(a0.y)} * rsa * ga; oa[1] = (f32x4){bflo(a0.z), bfhi(a0.z), bflo(a0.w), bfhi(a0.w)} * rsa * gb;
        oa[128] = (f32x4){bflo(a1.x), bfhi(a1.x), bflo(a1.y), bfhi(a1.y)} * rsa * gc; oa[129] = (f32x4){bflo(a1.z), bfhi(a1.z), bflo(a1.w), bfhi(a1.w)} * rsa * gd;
        if (two) { f32x4* ob = (f32x4*)(out + (size_t)m1 * D) + 2 * lane;
            ob[0] = (f32x4){bflo(b0.x), bfhi(b0.x), bflo(b0.y), bfhi(b0.y)} * rsb * ga; ob[1] = (f32x4){bflo(b0.z), bfhi(b0.z), bflo(b0.w), bfhi(b0.w)} * rsb * gb;
            ob[128] = (f32x4){bflo(b1.x), bfhi(b1.x), bflo(b1.y), bfhi(b1.y)} * rsb * gc; ob[129] = (f32x4){bflo(b1.z), bfhi(b1.z), bflo(b1.w), bfhi(b1.w)} * rsb * gd; }
    }
}
__device__ __forceinline__ void conv_phase(const bf16* Bg, const bf16* Z, const float* cw, bf16* MIX, int M, int L) {
    constexpr int CB = 4;
    int tid_ = threadIdx.x; asm volatile("" : "+v"(tid_));
    const size_t n = (size_t)M * (D / 8), stride = (size_t)gridDim.x * NTHR;
    const size_t start = (size_t)blockIdx.x * NTHR + tid_;
    const int c8 = (int)(start & 127) * 8;
    float w0[8], w1[8], w2[8];
#pragma unroll
    for (int x = 0; x < 8; ++x) { w0[x] = cw[c8 + x]; w1[x] = cw[D + c8 + x]; w2[x] = cw[2 * D + c8 + x]; }
    for (size_t idx = start; idx < n; idx += CB * stride) {
        v4u zc[CB], bg[CB], zm[CB], zp[CB]; bool ok[CB];
#pragma unroll
        for (int u = 0; u < CB; ++u) { const size_t id = idx + u * stride; ok[u] = id < n; const int t = ok[u] ? (int)(id >> 7) : 0; const int tl = t % L;
            zc[u] = *(const v4u*)(Z + (size_t)t * D + c8); bg[u] = *(const v4u*)(Bg + (size_t)t * D + c8);
            zm[u] = *(const v4u*)(Z + (size_t)(tl > 0 ? t - 1 : t) * D + c8); zp[u] = *(const v4u*)(Z + (size_t)(tl < L - 1 ? t + 1 : t) * D + c8);
            if (tl == 0) zm[u] = (v4u){0u, 0u, 0u, 0u};
            if (tl == L - 1) zp[u] = (v4u){0u, 0u, 0u, 0u}; }
#pragma unroll
        for (int u = 0; u < CB; ++u) { if (!ok[u]) continue; const int t = (int)((idx + u * stride) >> 7);
            v4u o;
#pragma unroll
            for (int q = 0; q < 4; ++q) {
                const float y0 = bflo(bg[u][q]) * (w0[2 * q] * bflo(zm[u][q]) + w1[2 * q] * bflo(zc[u][q]) + w2[2 * q] * bflo(zp[u][q]));
                const float y1 = bfhi(bg[u][q]) * (w0[2 * q + 1] * bfhi(zm[u][q]) + w1[2 * q + 1] * bfhi(zc[u][q]) + w2[2 * q + 1] * bfhi(zp[u][q]));
                o[q] = pk2(y0, y1); }
            *(v4u*)(MIX + (size_t)t * D + c8) = o; }
    }
}
#define XB_TMO      128
#define XB_XCNT(j)  (256  + 64 * (j))
#define XB_XSUB(j)  (1280 + 64 * (j))
#define XB_XGEN(j)  (2304 + 64 * (j))
#define XB_TOP      3328
#define XB_TOPGEN   3392
#define XCD_BAR_WORDS 3456
#define XB_SPIN_CAP (1u << 18)

__device__ __forceinline__ unsigned xb_ld(unsigned* p)              { return __hip_atomic_load(p, __ATOMIC_RELAXED, __HIP_MEMORY_SCOPE_AGENT); }
__device__ __forceinline__ unsigned xb_add(unsigned* p, unsigned v) { return __hip_atomic_fetch_add(p, v, __ATOMIC_RELAXED, __HIP_MEMORY_SCOPE_AGENT); }
__device__ __forceinline__ unsigned xb_xcc_id() { return (unsigned)__builtin_amdgcn_s_getreg((3 << 11) | 20) & 0xFu; }
#define XB_SPIN(cond, bar) do { unsigned _sp = 0; while (cond) { __builtin_amdgcn_s_sleep(1); \
    if ((++_sp & 255u) == 0u) { if (xb_ld(&(bar)[XB_TMO])) break; if (_sp > XB_SPIN_CAP) { atomicAdd(&(bar)[XB_TMO], 1u); break; } } } } while (0)

struct XcdBarrier {
    unsigned* bar; unsigned x;
    volatile LAS unsigned* st;
};

__device__ __forceinline__ XcdBarrier xcd_barrier_post(unsigned* bar, volatile LAS unsigned* st) {
    XcdBarrier b; b.bar = bar; b.x = xb_xcc_id(); b.st = st;
    if (threadIdx.x == 0) (void)xb_add(&bar[XB_XCNT(b.x)], 1u);
    return b;
}
__device__ __forceinline__ void xcd_barrier_complete(unsigned* bar, unsigned x, unsigned& nloc, unsigned& nx) {
    const unsigned G = gridDim.x * gridDim.y * gridDim.z;
    unsigned sum, cnt, mine, sp = 0u;
    for (;;) {
        sum = 0u; cnt = 0u; mine = 0u;
#pragma unroll
        for (unsigned j = 0; j < 16; ++j) { const unsigned c = xb_ld(&bar[XB_XCNT(j)]); sum += c; cnt += (c > 0u) ? 1u : 0u; mine = (j == x) ? c : mine; }
        if (sum == G) break;
        __builtin_amdgcn_s_sleep(1);
        if ((++sp & 255u) == 0u) { if (xb_ld(&bar[XB_TMO])) break; if (sp > XB_SPIN_CAP) { atomicAdd(&bar[XB_TMO], 1u); break; } }
    }
    nloc = mine > 0u ? mine : 1u; nx = cnt > 0u ? cnt : 1u;
}

__device__ __forceinline__ void xcd_barrier(const XcdBarrier& b) {
    asm volatile("s_waitcnt vmcnt(0)" ::: "memory");
    __syncthreads();
    if (threadIdx.x == 0) {
        unsigned* bar = b.bar;
        __builtin_amdgcn_s_waitcnt(0);
        unsigned nloc = b.st[0], nx = b.st[1];
        if (nloc == 0u) { xcd_barrier_complete(bar, b.x, nloc, nx); b.st[0] = nloc; b.st[1] = nx; }
        const unsigned old = xb_add(&bar[XB_XSUB(b.x)], 1u);
        const unsigned gen = old / nloc;
        if (old + 1u == (gen + 1u) * nloc) {
            __builtin_amdgcn_fence(__ATOMIC_RELEASE, "agent");
            asm volatile("s_waitcnt vmcnt(0)" ::: "memory");
            const unsigned og = xb_add(&bar[XB_TOP], 1u);
            const unsigned tg = og / nx;
            if (og + 1u == (tg + 1u) * nx) xb_add(&bar[XB_TOPGEN], 1u);
            else XB_SPIN(xb_ld(&bar[XB_TOPGEN]) == tg, bar);
            __builtin_amdgcn_fence(__ATOMIC_ACQUIRE, "agent");
            xb_add(&bar[XB_XGEN(b.x)], 1u);
            asm volatile("s_waitcnt vmcnt(0)" ::: "memory");
        } else {
            XB_SPIN(xb_ld(&bar[XB_XGEN(b.x)]) == gen, bar);
            __builtin_amdgcn_fence(__ATOMIC_ACQUIRE, "agent");
            asm volatile("s_waitcnt vmcnt(0)" ::: "memory");
        }
    }
    __syncthreads();
}
typedef short bf16x8 __attribute__((ext_vector_type(8)));
typedef float f32x16 __attribute__((ext_vector_type(16)));
typedef float f32x2v __attribute__((ext_vector_type(2)));
constexpr int HG = 128, LSTR = 272, IMG = 128 * LSTR;
__device__ __forceinline__ bf16x8 as_bf8(v4u w) { return __builtin_bit_cast(bf16x8, w); }
__device__ __forceinline__ float ex2(float x) { return __builtin_amdgcn_exp2f(x); }
__device__ __forceinline__ float lb_of(const float* lbl, int e, int dir, int c) { if (e == 0) return 0.f; const float l0 = lbl[dir * 512 + c], l1 = lbl[(2 + dir) * 512 + c]; return 1.0f / (1.0f + __expf(l0 - l1)); }
__device__ __forceinline__ void hgrn_gate(float z, float lb, float& lf, float& k) {
    const float sg = 1.0f / (1.0f + __expf(-z)); const float f = lb + (1.0f - lb) * sg; lf = fmaxf(__logf(f), -80.f); k = (1.0f - lb) / (1.0f + __expf(z));
}
__device__ __forceinline__ void hgrn_store_vt(const bf16* pr, LAS unsigned char* VT, int i, int tq) {
#pragma unroll
    for (int m = 0; m < 4; ++m) { v4u w;
#pragma unroll
        for (int x = 0; x < 4; ++x) { const unsigned lo = pr[(size_t)(8 * m + 2 * x) * EIN + 1536], hi = pr[(size_t)(8 * m + 2 * x + 1) * EIN + 1536]; w[x] = lo | (hi << 16); }
        *(LAS v4u*)(VT + i * LSTR + (32 * tq + 8 * m) * 2) = w; }
}
__device__ __forceinline__ void hgrn_ld_chunks(const bf16* base, int tid, v4u (&w)[4]) {
#pragma unroll
    for (int m = 0; m < 4; ++m) { const int cid = tid + 512 * m; w[m] = *(const v4u*)(base + (size_t)(cid >> 4) * EIN + 8 * (cid & 15)); }
}
__device__ __forceinline__ void hgrn_st_chunks(LAS unsigned char* R, int tid, const v4u (&w)[4]) {
#pragma unroll
    for (int m = 0; m < 4; ++m) { const int cid = tid + 512 * m; *(LAS v4u*)(R + (cid >> 4) * LSTR + (cid & 15) * 16) = w[m]; }
}
__device__ __forceinline__ void hgrn_build_vt(const LAS unsigned char* R, LAS unsigned char* VT, int i, int tq) {
    unsigned raw[32];
#pragma unroll
    for (int uu = 0; uu < 32; ++uu) raw[uu] = *(const LAS unsigned short*)(R + (32 * tq + uu) * LSTR + 2 * i);
    __builtin_amdgcn_sched_barrier(0);
#pragma unroll
    for (int m = 0; m < 4; ++m) { v4u w;
#pragma unroll
        for (int x = 0; x < 4; ++x) w[x] = raw[8 * m + 2 * x] | (raw[8 * m + 2 * x + 1] << 16);
        *(LAS v4u*)(VT + i * LSTR + (32 * tq + 8 * m) * 2) = w; }
}
__device__ __forceinline__ void hgrn_pass1(const bf16* PROJ, bf16* ST, float* DEC, const float* lbl, int e, int L, LAS unsigned char* lds) {
    int tid_ = threadIdx.x; asm volatile("" : "+v"(tid_)); const int tid = tid_, lane = tid & 63, wave = __builtin_amdgcn_readfirstlane(tid >> 6), i = tid & 127, tq = tid >> 7;
    const int nseg = L / HG, nunits = 8 * nseg;
    LAS unsigned char* VT = lds + 2 * IMG; LAS unsigned char* R0 = lds + 3 * IMG; LAS float* TOT = (LAS float*)(lds + 4 * IMG);
    for (int u = blockIdx.x; u < nunits; u += gridDim.x) {
        const int h = u & 3, sgi = u >> 2, seq = sgi / nseg, seg = sgi % nseg;
        const bf16* pb = PROJ + ((size_t)seq * L + (size_t)seg * HG) * EIN + 128 * h;
        v4u cv[4], cz[2][4];
        hgrn_ld_chunks(pb + 1536, tid, cv); hgrn_ld_chunks(pb + 512, tid, cz[0]); hgrn_ld_chunks(pb + 1024, tid, cz[1]);
        hgrn_st_chunks(R0, tid, cv);
        __syncthreads();
        hgrn_build_vt(R0, VT, i, tq);
#pragma unroll
        for (int dir = 0; dir < 2; ++dir) {
            __syncthreads();
            hgrn_st_chunks(R0, tid, cz[dir]);
            __syncthreads();
            float lf[32], kk[32]; float tot = 0.f;
#pragma unroll
            for (int uu = 0; uu < 32; ++uu) kk[uu] = __builtin_bit_cast(float, (unsigned)*(const LAS unsigned short*)(R0 + (32 * tq + uu) * LSTR + 2 * i));
            __builtin_amdgcn_sched_barrier(0);
#pragma unroll
            for (int uu = 0; uu < 32; ++uu) { lf[uu] = __builtin_bit_cast(float, __builtin_bit_cast(unsigned, kk[uu]) << 16); kk[uu] = 1.0f - ex2(lf[uu]); tot += lf[uu]; }
            TOT[(dir * 4 + tq) * 128 + i] = tot;
            __syncthreads();
            float off = 0.f, dtot = 0.f;
#pragma unroll
            for (int q = 0; q < 4; ++q) { const float tv = TOT[(dir * 4 + q) * 128 + i]; dtot += tv; if (dir == 0 ? (q > tq) : (q < tq)) off += tv; }
            if (tq == 0) DEC[(size_t)(u * 2 + dir) * 128 + i] = ex2(dtot);
            if (dir == 0) { float run = off;
#pragma unroll
                for (int uu = 31; uu >= 0; --uu) { kk[uu] *= ex2(run); run += lf[uu]; } }
            else { float run = off;
#pragma unroll
                for (int uu = 0; uu < 32; ++uu) { kk[uu] *= ex2(run); run += lf[uu]; } }
            LAS unsigned char* KT = lds + dir * IMG;
#pragma unroll
            for (int m = 0; m < 4; ++m) { v4u w;
#pragma unroll
                for (int x = 0; x < 4; ++x) w[x] = pk2(kk[8 * m + 2 * x], kk[8 * m + 2 * x + 1]);
                *(LAS v4u*)(KT + i * LSTR + (32 * tq + 8 * m) * 2) = w; }
        }
        __syncthreads();
        {
            const int dir = wave >> 2, it = wave & 3, r32 = lane & 31, hh = lane >> 5;
            const LAS unsigned char* KT = lds + dir * IMG;
            f32x16 acc[4];
#pragma unroll
            for (int jt = 0; jt < 4; ++jt)
#pragma unroll
                for (int x = 0; x < 16; ++x) acc[jt][x] = 0.f;
#pragma unroll
            for (int ks = 0; ks < 8; ++ks) {
                const bf16x8 a = *(const LAS bf16x8*)(KT + (32 * it + r32) * LSTR + (16 * ks + 8 * hh) * 2);
#pragma unroll
                for (int jt = 0; jt < 4; ++jt) { const bf16x8 b = *(const LAS bf16x8*)(VT + (32 * jt + r32) * LSTR + (16 * ks + 8 * hh) * 2);
                    acc[jt] = __builtin_amdgcn_mfma_f32_32x32x16_bf16(a, b, acc[jt], 0, 0, 0); }
            }
            bf16* Sg = ST + (size_t)(u * 2 + dir) * 16384;
#pragma unroll
            for (int jt = 0; jt < 4; ++jt)
#pragma unroll
                for (int g = 0; g < 4; ++g) { v2u w; w.x = pk2(acc[jt][4 * g], acc[jt][4 * g + 1]); w.y = pk2(acc[jt][4 * g + 2], acc[jt][4 * g + 3]);
                    *(v2u*)(Sg + (32 * jt + r32) * 128 + 32 * it + 8 * g + 4 * hh) = w; }
        }
        __syncthreads();
    }
}
__device__ __forceinline__ void hgrn_scan(bf16* ST, const float* DEC, int L) {
    const int nseg = L / HG;
    for (int idx = blockIdx.x * NTHR + threadIdx.x; idx < 2 * 4 * 2 * 8192; idx += gridDim.x * NTHR) {
        const int pr = idx & 8191, dir = (idx >> 13) & 1, h = (idx >> 14) & 3, seq = idx >> 16, i0 = (2 * pr) & 127;
        float r0 = 0.f, r1 = 0.f;
        for (int s0 = 0; s0 < nseg; s0 += 32) {
            unsigned w[32]; float d0[32], d1[32];
#pragma unroll
            for (int x = 0; x < 32; ++x) { const int seg = dir ? nseg - 1 - (s0 + x) : (s0 + x); const int u = (seq * nseg + seg) * 4 + h;
                w[x] = *((const unsigned*)(ST + (size_t)(u * 2 + dir) * 16384) + pr);
                const f32x2v dv = *(const f32x2v*)(DEC + (size_t)(u * 2 + dir) * 128 + i0); d0[x] = dv.x; d1[x] = dv.y; }
#pragma unroll
            for (int x = 0; x < 32; ++x) { const int seg = dir ? nseg - 1 - (s0 + x) : (s0 + x); const int u = (seq * nseg + seg) * 4 + h;
                *((unsigned*)(ST + (size_t)(u * 2 + dir) * 16384) + pr) = pk2(r0, r1);
                r0 = d0[x] * r0 + bflo(w[x]); r1 = d1[x] * r1 + bfhi(w[x]); }
        }
    }
}
__device__ __forceinline__ f32x4 mfma16(bf16x8 a, bf16x8 b, f32x4 c) { return __builtin_amdgcn_mfma_f32_16x16x32_bf16(a, b, c, 0, 0, 0); }
__device__ __forceinline__ bf16x8 scale_frag(v4u w, const float (&sc)[8]) {
    v4u o;
#pragma unroll
    for (int x = 0; x < 4; ++x) o[x] = pk2(bflo(w[x]) * sc[2 * x], bfhi(w[x]) * sc[2 * x + 1]);
    return as_bf8(o);
}
__device__ __forceinline__ void hgrn_pass2(const bf16* PROJ, const bf16* ST, const float* lbl, const float* gain, int e, bf16* MIX, int L, LAS unsigned char* lds) {
    int tid_ = threadIdx.x; asm volatile("" : "+v"(tid_)); const int tid = tid_, lane = tid & 63, wave = __builtin_amdgcn_readfirstlane(tid >> 6), i = tid & 127, tq = tid >> 7;
    const int r16 = lane & 15, g4 = lane >> 4, I = wave;
    const int nseg = L / HG, nunits = 8 * nseg;
    LAS unsigned char* BQ = lds; LAS unsigned char* BK = lds + IMG; LAS unsigned char* VT = lds + 2 * IMG;
    LAS unsigned char* SI = lds + 3 * IMG; LAS float* FT = (LAS float*)(lds + 4 * IMG);
    LAS float* TS = (LAS float*)(lds + 2 * IMG) + wave * 1024;
    for (int u = blockIdx.x; u < nunits; u += gridDim.x) {
        const int h = u & 3, sgi = u >> 2, seq = sgi / nseg, seg = sgi % nseg;
        const size_t rowseg = (size_t)seq * L + (size_t)seg * HG;
        const bf16* pb = PROJ + rowseg * EIN + 128 * h;
        __syncthreads();
        f32x4 O[8], X[8];
#pragma unroll
        for (int x = 0; x < 8; ++x) { O[x] = (f32x4){0.f, 0.f, 0.f, 0.f}; X[x] = (f32x4){0.f, 0.f, 0.f, 0.f}; }
#pragma unroll 1
        for (int dir = 0; dir < 2; ++dir) {
            v4u sreg[4];
            {   v4u cz[4], cq[4];
                hgrn_ld_chunks(pb + 512 + 512 * dir, tid, cz); hgrn_ld_chunks(pb, tid, cq);
                const bf16* Sg = ST + (size_t)(u * 2 + dir) * 16384;
#pragma unroll
                for (int m = 0; m < 4; ++m) sreg[m] = *(const v4u*)(Sg + (size_t)(tid + 512 * m) * 8);
                hgrn_st_chunks(BK, tid, cz); hgrn_st_chunks(BQ, tid, cq); }
            __syncthreads();
#pragma unroll
            for (int m = 0; m < 4; ++m) { const int c = tid + 512 * m; *(LAS v4u*)(SI + (c >> 4) * LSTR + (c & 15) * 16) = sreg[m]; }
#pragma unroll 1
            for (int b = 0; b < 2; ++b) {
                LAS unsigned char* qp = BQ + (32 * tq + 16 * b) * LSTR + 2 * i; LAS unsigned char* kp = BK + (32 * tq + 16 * b) * LSTR + 2 * i;
                float lf[16], kk[16], qq[16];
#pragma unroll
                for (int uu = 0; uu < 16; ++uu) { lf[uu] = bf2f(*(const LAS unsigned short*)(kp + uu * LSTR)); qq[uu] = bf2f(*(const LAS unsigned short*)(qp + uu * LSTR)); }
                __builtin_amdgcn_sched_barrier(0);
#pragma unroll
                for (int uu = 0; uu < 16; ++uu) kk[uu] = 1.0f - ex2(lf[uu]);
                float run = 0.f;
                if (dir == 0) {
#pragma unroll
                    for (int t = 0; t < 16; ++t) { run += lf[t]; qq[t] *= ex2(run); }
                    FT[(2 * tq + b + 1) * 128 + i] = run; run = 0.f;
#pragma unroll
                    for (int t = 15; t >= 0; --t) { kk[t] *= ex2(run); run += lf[t]; }
                } else {
#pragma unroll
                    for (int t = 15; t >= 0; --t) { run += lf[t]; qq[t] *= ex2(run); }
                    FT[(2 * tq + b + 1) * 128 + i] = run; run = 0.f;
#pragma unroll
                    for (int t = 0; t < 16; ++t) { kk[t] *= ex2(run); run += lf[t]; }
                }
#pragma unroll
                for (int uu = 0; uu < 16; ++uu) { *(LAS unsigned short*)(qp + uu * LSTR) = (unsigned short)f2bf(qq[uu]); *(LAS unsigned short*)(kp + uu * LSTR) = (unsigned short)f2bf(kk[uu]); }
            }
            __syncthreads();
            if (tq == 0) { float run = 0.f; FT[i] = 0.f;
#pragma unroll
                for (int J = 1; J <= 8; ++J) { run += FT[J * 128 + i]; FT[J * 128 + i] = run; } }
            __syncthreads();
#pragma unroll
            for (int J = 0; J < 8; ++J) {
                if (dir == 0 ? (J <= I) : (J >= I)) {
                    const LAS float* FA = FT + (dir == 0 ? I : J) * 128; const LAS float* FB = FT + (dir == 0 ? J + 1 : I + 1) * 128;
                    const f32x2v a = *(const LAS f32x2v*)(FA + 2 * lane), b = *(const LAS f32x2v*)(FB + 2 * lane);
                    *(LAS f32x2v*)(TS + J * 128 + 2 * lane) = (f32x2v){ex2(a.x - b.x), ex2(a.y - b.y)}; } }
            bf16x8 qf[4];
#pragma unroll
            for (int ks = 0; ks < 4; ++ks) qf[ks] = *(const LAS bf16x8*)(BQ + (16 * I + r16) * LSTR + (32 * ks + 8 * g4) * 2);
#pragma unroll
            for (int J = 0; J < 8; ++J) {
                if (dir == 0 ? (J <= I) : (J >= I)) {
                    f32x4 acc = (f32x4){0.f, 0.f, 0.f, 0.f};
#pragma unroll
                    for (int ks = 0; ks < 4; ++ks) {
                        const int i0 = 32 * ks + 8 * g4;
                        const v4u kw = *(const LAS v4u*)(BK + (16 * J + r16) * LSTR + i0 * 2);
                        const f32x4 s0 = *(const LAS f32x4*)(TS + J * 128 + i0), s1 = *(const LAS f32x4*)(TS + J * 128 + i0 + 4);
                        const float sc[8] = {s0[0], s0[1], s0[2], s0[3], s1[0], s1[1], s1[2], s1[3]};
                        acc = mfma16(scale_frag(kw, sc), qf[ks], acc);
                    }
                    if (J == I) {
#pragma unroll
                        for (int r = 0; r < 4; ++r) { const int s = 4 * g4 + r; const bool keep = dir == 0 ? (s <= r16) : (s >= r16); acc[r] = keep ? acc[r] : 0.f; }
                    }
                    X[J] += acc;
                }
            }
            {
                const LAS float* FA = FT + (dir == 0 ? I : 8) * 128; const LAS float* FB = FT + (dir == 0 ? 0 : I + 1) * 128;
                bf16x8 qh[4];
#pragma unroll
                for (int ks = 0; ks < 4; ++ks) { const int i0 = 32 * ks + 8 * g4;
                    const f32x4 a0 = *(const LAS f32x4*)(FA + i0), a1 = *(const LAS f32x4*)(FA + i0 + 4), b0 = *(const LAS f32x4*)(FB + i0), b1 = *(const LAS f32x4*)(FB + i0 + 4);
                    float sc[8];
#pragma unroll
                    for (int x = 0; x < 4; ++x) { sc[x] = ex2(a0[x] - b0[x]); sc[4 + x] = ex2(a1[x] - b1[x]); }
                    qh[ks] = scale_frag(__builtin_bit_cast(v4u, qf[ks]), sc); }
#pragma unroll
                for (int dt = 0; dt < 8; ++dt)
#pragma unroll
                    for (int ks = 0; ks < 4; ++ks) { const bf16x8 bfr = *(const LAS bf16x8*)(SI + (16 * dt + r16) * LSTR + (32 * ks + 8 * g4) * 2); O[dt] = mfma16(qh[ks], bfr, O[dt]); }
            }
            __syncthreads();
        }
        { v4u cv[4]; hgrn_ld_chunks(pb + 1536, tid, cv); hgrn_st_chunks(SI, tid, cv); }
        __syncthreads();
        hgrn_build_vt(SI, VT, i, tq);
        v4u gch[4];
#pragma unroll
        for (int m = 0; m < 4; ++m) { const int cc = lane + 64 * m; gch[m] = *(const v4u*)(pb + (size_t)(16 * I + (cc >> 4)) * EIN + 2048 + 8 * (cc & 15)); }
        __syncthreads();
#pragma unroll
        for (int kp = 0; kp < 4; ++kp) {
            v4u aw; aw.x = pk2(X[2 * kp][0], X[2 * kp][1]); aw.y = pk2(X[2 * kp][2], X[2 * kp][3]); aw.z = pk2(X[2 * kp + 1][0], X[2 * kp + 1][1]); aw.w = pk2(X[2 * kp + 1][2], X[2 * kp + 1][3]);
            const bf16x8 af = as_bf8(aw);
#pragma unroll
            for (int dt = 0; dt < 8; ++dt) { const LAS unsigned char* vr = VT + (16 * dt + r16) * LSTR;
                const v2u lo = *(const LAS v2u*)(vr + (32 * kp + 4 * g4) * 2), hi = *(const LAS v2u*)(vr + (32 * kp + 16 + 4 * g4) * 2);
                v4u bw; bw.x = lo.x; bw.y = lo.y; bw.z = hi.x; bw.w = hi.y;
                O[dt] = mfma16(af, as_bf8(bw), O[dt]); }
        }
#pragma unroll
        for (int r = 0; r < 4; ++r) { float ss = 0.f;
#pragma unroll
            for (int dt = 0; dt < 8; ++dt) ss += O[dt][r] * O[dt][r];
            ss += __shfl_xor(ss, 1); ss += __shfl_xor(ss, 2); ss += __shfl_xor(ss, 4); ss += __shfl_xor(ss, 8);
            const float rs = rsqrtf(ss * (1.0f / 128.0f) + 1e-6f);
#pragma unroll
            for (int dt = 0; dt < 8; ++dt) *(LAS unsigned short*)(BQ + (16 * I + 4 * g4 + r) * LSTR + (16 * dt + r16) * 2) = (unsigned short)f2bf(O[dt][r] * rs); }
#pragma unroll
        for (int m = 0; m < 4; ++m) { const int cc = lane + 64 * m, tl = cc >> 4, c8 = cc & 15;
            const v4u ow = *(const LAS v4u*)(BQ + (16 * I + tl) * LSTR + c8 * 16);
            const f32x4 ga = *(const f32x4*)(gain + 128 * h + 8 * c8), gb = *(const f32x4*)(gain + 128 * h + 8 * c8 + 4);
            v4u yw;
#pragma unroll
            for (int x = 0; x < 4; ++x) { const float g0 = bflo(gch[m][x]), g1 = bfhi(gch[m][x]);
                const float y0 = bflo(ow[x]) * (x < 2 ? ga[2 * x] : gb[2 * x - 4]) * g0;
                const float y1 = bfhi(ow[x]) * (x < 2 ? ga[2 * x + 1] : gb[2 * x - 3]) * g1;
                yw[x] = pk2(y0, y1); }
            *(v4u*)(MIX + (rowseg + 16 * I + tl) * D + 128 * h + 8 * c8) = yw; }
    }
}
typedef short s16x4 __attribute__((ext_vector_type(4)));
__device__ __forceinline__ int clampi(int v, int lo, int hi) { return v < lo ? lo : (v > hi ? hi : v); }
template <int OFF> __device__ __forceinline__ void tr_read8(const unsigned (&a)[8], s16x4 (&r)[8]) {
    asm volatile("ds_read_b64_tr_b16 %0, %8 offset:%16\n\tds_read_b64_tr_b16 %1, %9 offset:%16\n\tds_read_b64_tr_b16 %2, %10 offset:%16\n\tds_read_b64_tr_b16 %3, %11 offset:%16\n\t"
                 "ds_read_b64_tr_b16 %4, %12 offset:%16\n\tds_read_b64_tr_b16 %5, %13 offset:%16\n\tds_read_b64_tr_b16 %6, %14 offset:%16\n\tds_read_b64_tr_b16 %7, %15 offset:%16\n\ts_waitcnt lgkmcnt(0)"
                 : "=&v"(r[0]), "=&v"(r[1]), "=&v"(r[2]), "=&v"(r[3]), "=&v"(r[4]), "=&v"(r[5]), "=&v"(r[6]), "=&v"(r[7])
                 : "v"(a[0]), "v"(a[1]), "v"(a[2]), "v"(a[3]), "v"(a[4]), "v"(a[5]), "v"(a[6]), "v"(a[7]), "i"(OFF) : "memory");
}
template <int KP> __device__ __forceinline__ void na_pv_step(const f32x4 (&X)[16], float inv, const unsigned (&ad)[8], int rs0, f32x4 (&O)[4]) {
    v4u aw; aw.x = pk2(X[2 * KP][0] * inv, X[2 * KP][1] * inv); aw.y = pk2(X[2 * KP][2] * inv, X[2 * KP][3] * inv);
    aw.z = pk2(X[2 * KP + 1][0] * inv, X[2 * KP + 1][1] * inv); aw.w = pk2(X[2 * KP + 1][2] * inv, X[2 * KP + 1][3] * inv);
    const unsigned soff = (unsigned)((rs0 + KP) & 7) * 8192u;
    unsigned b[8]; s16x4 vr[8];
#pragma unroll
    for (int x = 0; x < 8; ++x) b[x] = ad[x] + soff;
    tr_read8<0>(b, vr);
    const bf16x8 af = as_bf8(aw);
#pragma unroll
    for (int dt = 0; dt < 4; ++dt) { const bf16x8 bw = (bf16x8){vr[2 * dt][0], vr[2 * dt][1], vr[2 * dt][2], vr[2 * dt][3], vr[2 * dt + 1][0], vr[2 * dt + 1][1], vr[2 * dt + 1][2], vr[2 * dt + 1][3]};
        O[dt] = mfma16(af, bw, O[dt]); }
}
__device__ __forceinline__ void na_fast(const bf16* PROJ, const float* rpb, bf16* MIX, int L, LAS unsigned char* lds) {
    int tid_ = threadIdx.x; asm volatile("" : "+v"(tid_)); const int tid = tid_, lane = tid & 63, wave = __builtin_amdgcn_readfirstlane(tid >> 6);
    const int r16 = lane & 15, g4 = lane >> 4;
    const int rows = L / 64, nunits = 2 * rows * 4;
    LAS unsigned char* VI = lds; LAS float* RP = (LAS float*)(lds + 131072);
    const unsigned vi_base = (unsigned)(size_t)VI;
    const int j = wave & 3, hh = wave >> 2;
    const int bs = clampi(16 * j - 8, 0, 32), qc = 16 * j + r16, ws0 = clampi(qc - 8, 0, 48);
    bool val[8]; int dcv[8];
#pragma unroll
    for (int c8 = 0; c8 < 8; ++c8) { const int kc = bs + 16 * (c8 >> 2) + 4 * g4 + (c8 & 3); val[c8] = (kc >= ws0) && (kc < ws0 + 16); dcv[c8] = clampi(kc - qc, -15, 15) + 15; }
    unsigned ad[8];
    { const int q4 = r16 >> 2, p4 = r16 & 3, keyA = bs + 4 * g4 + q4, keyB = keyA + 16;
#pragma unroll
      for (int dt = 0; dt < 4; ++dt) {
          ad[2 * dt] = vi_base + hh * 65536 + keyA * 128 + (((2 * dt + (p4 >> 1)) ^ (((keyA >> 1) & 3) * 2)) * 16) + (p4 & 1) * 8;
          ad[2 * dt + 1] = vi_base + hh * 65536 + keyB * 128 + (((2 * dt + (p4 >> 1)) ^ (((keyB >> 1) & 3) * 2)) * 16) + (p4 & 1) * 8; } }
    const int RPS = rows >= 256 ? 8 : 4, nstrips = 8 * (rows / RPS);
    (void)nunits;
    for (int strip = blockIdx.x; strip < nstrips; strip += gridDim.x) {
      const int hp = strip & 3, seq = (strip >> 2) & 1, r0 = (strip >> 3) * RPS;
      const size_t seqbase = (size_t)seq * L;
      __syncthreads();
      { const int rs0 = clampi(r0 - 4, 0, rows - 8);
#pragma unroll 1
        for (int mb = 0; mb < 16; mb += 4) {
            v4u wv[4];
#pragma unroll
            for (int m = 0; m < 4; ++m) { const int cid = tid + 512 * (mb + m), c = cid & 7, h2 = (cid >> 3) & 1, key = cid >> 4;
                wv[m] = *(const v4u*)(PROJ + (seqbase + (size_t)(rs0 * 64 + key)) * EIN + 3584 + 64 * (2 * hp + h2) + 8 * c); }
#pragma unroll
            for (int m = 0; m < 4; ++m) { const int cid = tid + 512 * (mb + m), c = cid & 7, h2 = (cid >> 3) & 1, key = cid >> 4, col = key & 63, slot = (rs0 + (key >> 6)) & 7;
                *(LAS v4u*)(VI + h2 * 65536 + (slot * 64 + col) * 128 + ((c ^ (((col >> 1) & 3) * 2)) * 16)) = wv[m]; } }
        for (int x = tid; x < 930; x += NTHR) RP[x] = rpb[(2 * hp) * 465 + x]; }
      for (int r = r0; r < r0 + RPS; ++r) {
        const int rs0 = clampi(r - 4, 0, rows - 8), rs0n = clampi(r + 1 - 4, 0, rows - 8);
        const bool more = (r + 1 < r0 + RPS) && (rs0n != rs0);
        __syncthreads();
        v4u nw[2];
        if (more) {
#pragma unroll
            for (int m = 0; m < 2; ++m) { const int cid = tid + 512 * m, c = cid & 7, h2 = (cid >> 3) & 1, col = cid >> 4;
                nw[m] = *(const v4u*)(PROJ + (seqbase + (size_t)((rs0n + 7) * 64 + col)) * EIN + 3584 + 64 * (2 * hp + h2) + 8 * c); } }
        const int h = 2 * hp + hh;
        const size_t qtok = seqbase + (size_t)r * 64 + qc;
        bf16x8 qf[2];
#pragma unroll
        for (int ks = 0; ks < 2; ++ks) qf[ks] = *(const bf16x8*)(PROJ + qtok * EIN + 2560 + 64 * h + 32 * ks + 8 * g4);
        f32x4 X[16];
        {
            const bf16* kbase = PROJ + (seqbase + (size_t)(rs0 * 64 + bs + r16)) * EIN + 3072 + 64 * h + 8 * g4;
            bf16x8 k0[16], k1[16];
#pragma unroll
            for (int T = 0; T < 8; ++T) { const bf16* kp = kbase + (size_t)((T >> 1) * 64 + 16 * (T & 1)) * EIN; k0[2 * T] = *(const bf16x8*)kp; k0[2 * T + 1] = *(const bf16x8*)(kp + 32); }
#pragma unroll
            for (int T = 8; T < 16; ++T) { const bf16* kp = kbase + (size_t)((T >> 1) * 64 + 16 * (T & 1)) * EIN; k1[2 * (T - 8)] = *(const bf16x8*)kp; k1[2 * (T - 8) + 1] = *(const bf16x8*)(kp + 32); }
            __builtin_amdgcn_sched_barrier(0);
#pragma unroll
            for (int T = 0; T < 8; ++T) { f32x4 acc = (f32x4){0.f, 0.f, 0.f, 0.f}; acc = mfma16(k0[2 * T], qf[0], acc); X[T] = mfma16(k0[2 * T + 1], qf[1], acc); }
#pragma unroll
            for (int T = 8; T < 16; ++T) { f32x4 acc = (f32x4){0.f, 0.f, 0.f, 0.f}; acc = mfma16(k1[2 * (T - 8)], qf[0], acc); X[T] = mfma16(k1[2 * (T - 8) + 1], qf[1], acc); }
        }
        const LAS float* rp = RP + hh * 465 + (rs0 - r + 7) * 31;
        float mx = -1e30f;
#pragma unroll
        for (int T = 0; T < 16; ++T) { const int kr = T >> 1, half = T & 1;
#pragma unroll
            for (int rr = 0; rr < 4; ++rr) { const int c8 = half * 4 + rr;
                const float sc = X[T][rr] * 0.125f + rp[kr * 31 + dcv[c8]];
                X[T][rr] = val[c8] ? sc : -1e30f; mx = fmaxf(mx, X[T][rr]); } }
        mx = fmaxf(mx, __shfl_xor(mx, 16)); mx = fmaxf(mx, __shfl_xor(mx, 32));
        float sum = 0.f;
#pragma unroll
        for (int T = 0; T < 16; ++T)
#pragma unroll
            for (int rr = 0; rr < 4; ++rr) { const float pw = __expf(X[T][rr] - mx); X[T][rr] = pw; sum += pw; }
        sum += __shfl_xor(sum, 16); sum += __shfl_xor(sum, 32);
        const float inv = 1.0f / sum;
        f32x4 O[4];
#pragma unroll
        for (int dt = 0; dt < 4; ++dt) O[dt] = (f32x4){0.f, 0.f, 0.f, 0.f};
        na_pv_step<0>(X, inv, ad, rs0, O); na_pv_step<1>(X, inv, ad, rs0, O); na_pv_step<2>(X, inv, ad, rs0, O); na_pv_step<3>(X, inv, ad, rs0, O);
        na_pv_step<4>(X, inv, ad, rs0, O); na_pv_step<5>(X, inv, ad, rs0, O); na_pv_step<6>(X, inv, ad, rs0, O); na_pv_step<7>(X, inv, ad, rs0, O);
#pragma unroll
        for (int dt = 0; dt < 4; ++dt)
#pragma unroll
            for (int rr = 0; rr < 4; ++rr) MIX[(seqbase + (size_t)r * 64 + 16 * j + 4 * g4 + rr) * D + 512 + 64 * h + 16 * dt + r16] = (bf16)f2bf(O[dt][rr]);
        if (more) {
            __syncthreads();
#pragma unroll
            for (int m = 0; m < 2; ++m) { const int cid = tid + 512 * m, c = cid & 7, h2 = (cid >> 3) & 1, col = cid >> 4, slot = (rs0n + 7) & 7;
                *(LAS v4u*)(VI + h2 * 65536 + (slot * 64 + col) * 128 + ((c ^ (((col >> 1) & 3) * 2)) * 16)) = nw[m]; } }
      }
    }
}
template <class Epi> __device__ __forceinline__ void run_gemm(LAS unsigned char* lds, const bf16* A, const bf16* Bt, int M, int N, int K, const Epi& E) {
    pg8::Gemm g{A, Bt, M, N, K}; pg8::StaticOrder S; S.init(M, N, (int)gridDim.x, (int)blockIdx.x);
    pg8::gemm_phase<Epi, pg8::StaticOrder, true, true>(lds, g, S, E);
}
constexpr int RS_OFF = 131072, RS_SLOTS = 18;
static_assert(RS_OFF + RS_SLOTS * 1024 + 64 <= LDS_BYTES, "row-scale table");
__device__ __forceinline__ void stage_row_scales(LAS unsigned char* lds, const float* SS, int M, int N) {
    pg8::StaticOrder S; S.init(M, N, (int)gridDim.x, (int)blockIdx.x);
    LAS float* RS = (LAS float*)(lds + RS_OFF);
    const int t = threadIdx.x & 255, half = threadIdx.x >> 8;
    pg8::Unit u;
    for (int i = half; i < RS_SLOTS && S.next(i, u); i += 2) RS[i * 256 + t] = pg8::row_rs(SS, u.pm * 256 + t);
    __syncthreads();
}
#ifndef HGRN_SLOW
#define HGRN_SLOW 0
#endif
#ifndef MK_ONE_LAUNCH
#define MK_ONE_LAUNCH 1
#endif
enum { K_PX = 0, K_E1, K_E2, K_ES, K_E3, K_C1, K_C2, K_RES, K_F1, K_FN };
constexpr int PH_PER_PASS = 26;
__global__ void __launch_bounds__(NTHR, 2) fwd_kernel(Params p) {
    extern __shared__ __attribute__((aligned(16))) unsigned char lds_raw[];
    LAS unsigned char* lds = (LAS unsigned char*)lds_raw;
    cg::grid_group grid = cg::this_grid();
    volatile LAS unsigned* bst = (volatile LAS unsigned*)(lds + LDS_BYTES - 64);
    if (threadIdx.x < 2) bst[threadIdx.x] = 0u;
    __syncthreads();
    XcdBarrier bar = xcd_barrier_post((unsigned*)p.ws, bst);
    for (int ph = p.ph_lo; ph < p.ph_hi; ++ph) {
        int tid_ = threadIdx.x; asm volatile("" : "+v"(tid_)); const int tid = tid_, lane = tid & 63, wave = __builtin_amdgcn_readfirstlane(tid >> 6);
        (void)tid;
        const int mode = p.mode, g = ph / PH_PER_PASS, idx = ph % PH_PER_PASS;
        int kind, l = 0, sub = 0;
        if (idx == 0) kind = K_PX; else if (idx == 25) kind = K_FN;
        else { const int j = idx - 1, pair = j / 12, r = j % 12;
            if (r < 7) { l = 2 * pair; kind = r == 0 ? K_E1 : r == 1 ? K_E2 : r == 2 ? K_ES : r == 3 ? K_E3 : r == 4 ? K_RES : r == 5 ? K_F1 : K_RES; sub = (r == 6); }
            else { l = 2 * pair + 1; const int r2 = r - 7; kind = r2 == 0 ? K_C1 : r2 == 1 ? K_C2 : r2 == 2 ? K_RES : r2 == 3 ? K_F1 : K_RES; sub = (r2 == 4); } }
        const int e = l >> 1;
        const int np = mode ? 2 : 1;
        const int gM = mode ? 49152 : (g ? 16384 : 32768);
        const size_t brows = mode ? 49152 : 32768;
        unsigned char* ws = p.ws;
        bf16* const XB = (bf16*)(ws + WS_XB); bf16* const MIX = XB + brows * D; bf16* const PROJ = MIX + brows * D; float* const SS = (float*)(ws + WS_SS);
#define PART(k) const int tr = mode ? (k) : g; const int Mk = tr ? 16384 : 32768, Lk = tr ? 8192 : 16384; const size_t r0 = (mode && tr) ? 32768 : 0; \
        const float* xin = tr ? p.x_sample : p.x_prompt; float* xres = p.out + (size_t)(tr ? 32768 : 0) * D; float* dec = (float*)(ws + WS_DEC) + ((mode && tr) ? 262144 : 0); (void)Mk; (void)Lk; (void)xin; (void)xres; (void)dec; (void)r0;
        switch (kind) {
        case K_PX: { if (g == 0) convert_weights(p, lds, wave, lane);
            for (int k = 0; k < np; ++k) { PART(k) px_phase(xin, XB + r0 * D, SS + r0 * 16, Mk, wave, lane); } } break;
        case K_E1: { stage_row_scales(lds, SS, gM, EIN); run_gemm(lds, XB, (const bf16*)(ws + WS_WEIN) + (size_t)e * EIN * D, gM, EIN, D, pg8::EpiEven{PROJ, (const LAS float*)(lds + RS_OFF), p.lb_logits, e}); } break;
        case K_E2: { for (int k = 0; k < np; ++k) { PART(k) hgrn_pass1(PROJ + r0 * EIN, (bf16*)xres, dec, p.lb_logits, e, Lk, lds); }
                     for (int k = 0; k < np; ++k) { PART(k) na_fast(PROJ + r0 * EIN, p.na_rpb + (size_t)e * 8 * 15 * 31, MIX + r0 * D, Lk, lds); } } break;
        case K_ES: { for (int k = 0; k < np; ++k) { PART(k) hgrn_scan((bf16*)xres, dec, Lk); } } break;
        case K_E3: { for (int k = 0; k < np; ++k) { PART(k) hgrn_pass2(PROJ + r0 * EIN, (const bf16*)xres, p.lb_logits, p.hgrn_norm + e * 512, e, MIX + r0 * D, Lk, lds); } } break;
        case K_C1: { stage_row_scales(lds, SS, gM, CIN); run_gemm(lds, XB, (const bf16*)(ws + WS_WCIN) + (size_t)e * CIN * D, gM, CIN, D, pg8::EpiConvIn{PROJ, PROJ + (size_t)gM * D, (const LAS float*)(lds + RS_OFF)}); } break;
        case K_C2: { for (int k = 0; k < np; ++k) { PART(k) conv_phase(PROJ + r0 * D, PROJ + (size_t)gM * D + r0 * D, p.conv_w + (size_t)e * 3 * D, MIX + r0 * D, Mk, Lk); } } break;
        case K_RES: {
            const bf16* A = sub ? PROJ : MIX;
            const bf16* Bt = sub ? (const bf16*)(ws + WS_WFOUT) + (size_t)l * D * DFF : ((l & 1) ? (const bf16*)(ws + WS_WCOUT) + (size_t)e * D * D : (const bf16*)(ws + WS_WEOUT) + (size_t)e * D * D);
            const int K = sub ? DFF : D;
            const bool first = (l == 0 && !sub);
            const float* ba = first ? (mode ? p.x_prompt : (g ? p.x_sample : p.x_prompt)) : nullptr;
            const float* bb = p.x_sample - (size_t)32768 * D;
            run_gemm(lds, A, Bt, gM, D, K, pg8::EpiResid{ba, bb, mode ? 128 : (1 << 30), nullptr, XB, SS}); } break;
        case K_F1: { stage_row_scales(lds, SS, gM, 2 * DFF); run_gemm(lds, XB, (const bf16*)(ws + WS_WFIN) + (size_t)l * 2 * DFF * D, gM, 2 * DFF, D, pg8::EpiSwiglu{PROJ, DFF, (const LAS float*)(lds + RS_OFF)}); } break;
        default: { final_norm(XB, p.out + (size_t)((!mode && g) ? 32768 : 0) * D, p.norm_final, SS, gM, wave, lane); } break;
        }
#undef PART
        if (ph + 1 < p.ph_hi) { if (p.ph_lo < 0) grid.sync(); else xcd_barrier(bar); }
    }
}

extern "C" void kernel_launch(void* const* d_in, const int* in_sizes, int n_in, void* d_out, int out_size, void* d_ws, size_t ws_size, hipStream_t stream) {
    static int grid = 0, mode = 0;
    if (grid == 0) {
        if (n_in != 15 || out_size != T_ALL * D || ws_size < WS_END_B) { fprintf(stderr, "kernel_launch: unexpected shapes / workspace (%d inputs, out %d, ws %zu)\n", n_in, out_size, ws_size); grid = -1; return; }
        if (hipFuncSetAttribute((const void*)fwd_kernel, hipFuncAttributeMaxDynamicSharedMemorySize, LDS_BYTES) != hipSuccess) { fprintf(stderr, "kernel_launch: hipFuncSetAttribute failed\n"); grid = -1; return; }
        int dev = 0, cus = 0, per_cu = 0;
        (void)hipGetDevice(&dev); (void)hipDeviceGetAttribute(&cus, hipDeviceAttributeMultiprocessorCount, dev);
        (void)hipOccupancyMaxActiveBlocksPerMultiprocessor(&per_cu, (const void*)fwd_kernel, NTHR, LDS_BYTES);
        if (per_cu < 1) fprintf(stderr, "kernel_launch: occupancy query says %d blocks per CU\n", per_cu);
        (void)hipGetLastError();
        grid = cus;
        mode = (ws_size >= WS_END_A && cus >= 236) ? 1 : 0;
        if (cus < 160) { fprintf(stderr, "kernel_launch: %d CUs: the per-workgroup row-scale table holds %d GEMM units; nothing launched\n", cus, RS_SLOTS); grid = -1; return; }
    }
    if (grid < 0) return;
    Params p{};
    p.x_prompt = (const float*)d_in[0]; p.x_sample = (const float*)d_in[1]; p.norm_mix = (const float*)d_in[2]; p.norm_ffn = (const float*)d_in[3]; p.norm_final = (const float*)d_in[4];
    p.even_w_in = (const float*)d_in[5]; p.even_w_out = (const float*)d_in[6]; p.lb_logits = (const float*)d_in[7]; p.hgrn_norm = (const float*)d_in[8]; p.na_rpb = (const float*)d_in[9];
    p.conv_w_in = (const float*)d_in[10]; p.conv_w = (const float*)d_in[11]; p.conv_w_out = (const float*)d_in[12]; p.ffn_w_in = (const float*)d_in[13]; p.ffn_w_out = (const float*)d_in[14];
    p.out = (float*)d_out; p.ws = (unsigned char*)d_ws; p.mode = mode;
    (void)hipMemsetAsync(d_ws, 0, XCD_BAR_WORDS * 4, stream);
    p.ph_lo = 0; p.ph_hi = PH_PER_PASS * (mode ? 1 : 2);
    void* args[] = {&p};
    hipError_t e = hipLaunchCooperativeKernel((const void*)fwd_kernel, dim3(grid), dim3(NTHR), args, LDS_BYTES, stream);
    if (e != hipSuccess) fprintf(stderr, "cooperative launch failed: %s (grid %d)\n", hipGetErrorString(e), grid);
}
```

```cpp
#include <hip/hip_runtime.h>
#include <hip/hip_cooperative_groups.h>
#include <cstdio>
#include <cstdint>
namespace cg = cooperative_groups;
namespace pg8 {
#define PG8_LAS __attribute__((address_space(3)))
typedef unsigned short bf16_t;
typedef short bf16x8 __attribute__((ext_vector_type(8)));
typedef float f32x4 __attribute__((ext_vector_type(4)));
typedef unsigned u32x4 __attribute__((ext_vector_type(4)));
constexpr int BM = 256, BK = 64, HALF = 128, HTB = HALF * BK * 2  , STAGE_BYTES = 8 * HTB, NXCD = 8, WGM = 8;

__host__ __device__ __forceinline__ int lds_byte(int r, int c) { const int st = (r >> 4) * 2 + (c >> 5), rr = r & 15, cc = c & 31, ob = rr * 64 + cc * 2; return st * 1024 + (ob ^ (((ob >> 9) & 1) << 5)); }
__host__ __device__ __forceinline__ void stage_rc(int b, int& R, int& C) { const int st = b / 1024, sb = b % 1024, swz = sb ^ (((sb >> 9) & 1) << 5); R = (st >> 1) * 16 + swz / 64; C = (st & 1) * 32 + (swz % 64) / 2; }
__host__ __device__ __forceinline__ int perm32(int rho) { const int n = rho >> 4, i = rho & 15; return 8 * (i >> 2) + 4 * n + (i & 3); }

struct Unit { int pm, pn, idx; };
struct Gemm { const bf16_t* A; const bf16_t* Bt; int M, N, K; };

struct StaticOrder {
    int nM, nN, nwg, G, c;
    __host__ __device__ void init(int M, int N, int G_, int c_) { nM = M / BM; nN = N / BM; nwg = nM * nN; G = G_; c = c_; }
    __host__ __device__ bool next(int i, Unit& u) const {
        const long L = (long)i * G + c; if (L >= nwg) return false;
        int wgid = (int)L; { const int q = nwg / NXCD, r = nwg % NXCD, xcd = wgid % NXCD, off = wgid / NXCD; wgid = (xcd < r ? xcd * (q + 1) : r * (q + 1) + (xcd - r) * q) + off; }
        const int nig = WGM * nN, gid = wgid / nig, fm = gid * WGM, gsz = (nM - fm) < WGM ? (nM - fm) : WGM;
        u.pm = fm + ((wgid % nig) % gsz); u.pn = (wgid % nig) / gsz; u.idx = i; return true;
    }
    __device__ __forceinline__ void a_ready(const Unit&) const {}
    __device__ __forceinline__ void done(const Unit&) const {}
};

typedef __bf16 bf16x2_e __attribute__((ext_vector_type(2)));
typedef float f32x2_e __attribute__((ext_vector_type(2)));
__device__ __forceinline__ unsigned cvt_pk_bf16(float lo, float hi) { const f32x2_e v = {lo, hi}; return __builtin_bit_cast(unsigned, __builtin_convertvector(v, bf16x2_e)); }
__device__ __forceinline__ float row_rs(const float* SS, int row) {
    const f32x4* p = (const f32x4*)(SS + (size_t)row * 16);
    const f32x4 a = p[0], b = p[1], c = p[2], d = p[3];
    const float s = ((a[0] + a[1]) + (a[2] + a[3])) + ((b[0] + b[1]) + (b[2] + b[3])) + ((c[0] + c[1]) + (c[2] + c[3])) + ((d[0] + d[1]) + (d[2] + d[3]));
    return rsqrtf(s * (1.0f / 1024.0f) + 1e-6f);
}
__device__ __forceinline__ float silu_f(float v) { return v * __builtin_amdgcn_rcpf(1.0f + __builtin_amdgcn_exp2f(-1.44269504f * v)); }
struct EpiScale {
    static constexpr bool PERM = true, AFTER_DRAIN = false;
    bf16_t* O; int ldc; const PG8_LAS float* RS;
    __device__ __forceinline__ void operator()(const f32x4 (&acc)[2][2][4][2], const Unit& u, int wr, int wc, int fr, int fq) const {
        const int row0 = u.pm * BM + wr * 64 + fr, col0 = u.pn * BM + wc * 32 + 8 * fq;
#pragma unroll
        for (int ai = 0; ai < 2; ++ai)
#pragma unroll
            for (int m = 0; m < 4; ++m) { const int row = row0 + ai * HALF + m * 16; const float rs = RS[u.idx * BM + wr * 64 + fr + ai * HALF + m * 16]; bf16_t* rowp = O + (size_t)row * ldc + col0;
#pragma unroll
                for (int bj = 0; bj < 2; ++bj) { const f32x4 v0 = acc[ai][bj][m][0] * rs, v1 = acc[ai][bj][m][1] * rs;
                    u32x4 w; w.x = cvt_pk_bf16(v0[0], v0[1]); w.y = cvt_pk_bf16(v0[2], v0[3]); w.z = cvt_pk_bf16(v1[0], v1[1]); w.w = cvt_pk_bf16(v1[2], v1[3]);
                    *(u32x4*)(rowp + bj * HALF) = w; } }
    }
};

struct EpiEven {
    static constexpr bool PERM = true, AFTER_DRAIN = false;
    bf16_t* O; const PG8_LAS float* RS; const float* lbl; int e;
    __device__ __forceinline__ void operator()(const f32x4 (&acc)[2][2][4][2], const Unit& u, int wr, int wc, int fr, int fq) const {
        const int row0 = u.pm * BM + wr * 64 + fr, col0 = u.pn * BM + wc * 32 + 8 * fq;
        const int pn = u.pn; const int mode = (pn < 2 || pn == 8 || pn == 9) ? 1 : ((pn >= 2 && pn < 6) ? 2 : 0);
        float lb[2][8];
#pragma unroll
        for (int bj = 0; bj < 2; ++bj)
#pragma unroll
            for (int x = 0; x < 8; ++x) lb[bj][x] = 0.f;
        if (mode == 2 && e == 1) { const int dir = pn >= 4, c0 = col0 - 512 - 512 * dir;
#pragma unroll
            for (int bj = 0; bj < 2; ++bj)
#pragma unroll
                for (int x = 0; x < 8; ++x) { const float l0 = lbl[dir * 512 + c0 + bj * HALF + x], l1 = lbl[(2 + dir) * 512 + c0 + bj * HALF + x]; lb[bj][x] = 1.0f / (1.0f + __expf(l0 - l1)); } }
#pragma unroll
        for (int ai = 0; ai < 2; ++ai)
#pragma unroll
            for (int m = 0; m < 4; ++m) { const int row = row0 + ai * HALF + m * 16; const float rs = RS[u.idx * BM + wr * 64 + fr + ai * HALF + m * 16]; bf16_t* rowp = O + (size_t)row * 4096 + col0;
#pragma unroll
                for (int bj = 0; bj < 2; ++bj) { float v[8];
#pragma unroll
                    for (int x = 0; x < 8; ++x) v[x] = acc[ai][bj][m][x >> 2][x & 3] * rs;
                    if (mode == 1) {
#pragma unroll
                        for (int x = 0; x < 8; ++x) v[x] = v[x] * __builtin_amdgcn_rcpf(1.0f + __builtin_amdgcn_exp2f(-1.44269504f * v[x]));
                    } else if (mode == 2) {
#pragma unroll
                        for (int x = 0; x < 8; ++x) { const float sg = __builtin_amdgcn_rcpf(1.0f + __builtin_amdgcn_exp2f(-1.44269504f * v[x])); v[x] = fmaxf(__builtin_amdgcn_logf(lb[bj][x] + (1.0f - lb[bj][x]) * sg), -115.f); }
                    }
                    u32x4 w; w.x = cvt_pk_bf16(v[0], v[1]); w.y = cvt_pk_bf16(v[2], v[3]); w.z = cvt_pk_bf16(v[4], v[5]); w.w = cvt_pk_bf16(v[6], v[7]);
                    *(u32x4*)(rowp + bj * HALF) = w; } }
    }
};
struct EpiSwiglu {
    static constexpr bool PERM = true, AFTER_DRAIN = false;
    bf16_t* H; int ldh; const PG8_LAS float* RS;
    __device__ __forceinline__ void operator()(const f32x4 (&acc)[2][2][4][2], const Unit& u, int wr, int wc, int fr, int fq) const {
        const int row0 = u.pm * BM + wr * 64 + fr, col0 = u.pn * HALF + wc * 32 + 8 * fq;
#pragma unroll
        for (int ai = 0; ai < 2; ++ai)
#pragma unroll
            for (int m = 0; m < 4; ++m) { const int row = row0 + ai * HALF + m * 16; const float rs = RS[u.idx * BM + wr * 64 + fr + ai * HALF + m * 16];
                const float c = -1.44269504f * rs, rs2 = rs * rs;
                f32x4 h[2];
#pragma unroll
                for (int n = 0; n < 2; ++n) {
                    const f32x4 g = acc[ai][0][m][n], up = acc[ai][1][m][n];
                    const f32x4 t = g * c; f32x4 d;
#pragma unroll
                    for (int x = 0; x < 4; ++x) d[x] = __builtin_amdgcn_exp2f(t[x]);
                    d = d + 1.0f;
#pragma unroll
                    for (int x = 0; x < 4; ++x) d[x] = __builtin_amdgcn_rcpf(d[x]);
                    h[n] = (g * up) * rs2 * d; }
                u32x4 w; w.x = cvt_pk_bf16(h[0][0], h[0][1]); w.y = cvt_pk_bf16(h[0][2], h[0][3]); w.z = cvt_pk_bf16(h[1][0], h[1][1]); w.w = cvt_pk_bf16(h[1][2], h[1][3]);
                *(u32x4*)(H + (size_t)row * ldh + col0) = w; }
    }
};
struct EpiConvIn {
    static constexpr bool PERM = true, AFTER_DRAIN = false;
    bf16_t* Bg; bf16_t* Z; const PG8_LAS float* RS;
    __device__ __forceinline__ void operator()(const f32x4 (&acc)[2][2][4][2], const Unit& u, int wr, int wc, int fr, int fq) const {
        const int row0 = u.pm * BM + wr * 64 + fr;
        if (u.pn < 4) {
            const int col0 = u.pn * BM + wc * 32 + 8 * fq;
#pragma unroll
            for (int ai = 0; ai < 2; ++ai)
#pragma unroll
                for (int m = 0; m < 4; ++m) { const int row = row0 + ai * HALF + m * 16; const float rs = RS[u.idx * BM + wr * 64 + fr + ai * HALF + m * 16]; bf16_t* rowp = Bg + (size_t)row * 1024 + col0;
#pragma unroll
                    for (int bj = 0; bj < 2; ++bj) { const f32x4 v0 = acc[ai][bj][m][0] * rs, v1 = acc[ai][bj][m][1] * rs;
                        u32x4 w; w.x = cvt_pk_bf16(v0[0], v0[1]); w.y = cvt_pk_bf16(v0[2], v0[3]); w.z = cvt_pk_bf16(v1[0], v1[1]); w.w = cvt_pk_bf16(v1[2], v1[3]);
                        *(u32x4*)(rowp + bj * HALF) = w; } }
        } else {
            const int col0 = (u.pn - 4) * HALF + wc * 32 + 8 * fq;
#pragma unroll
            for (int ai = 0; ai < 2; ++ai)
#pragma unroll
                for (int m = 0; m < 4; ++m) { const int row = row0 + ai * HALF + m * 16; const float rs = RS[u.idx * BM + wr * 64 + fr + ai * HALF + m * 16]; const float rs2 = rs * rs;
                    const f32x4 z0 = acc[ai][0][m][0] * acc[ai][1][m][0] * rs2, z1 = acc[ai][0][m][1] * acc[ai][1][m][1] * rs2;
                    u32x4 w; w.x = cvt_pk_bf16(z0[0], z0[1]); w.y = cvt_pk_bf16(z0[2], z0[3]); w.z = cvt_pk_bf16(z1[0], z1[1]); w.w = cvt_pk_bf16(z1[2], z1[3]);
                    *(u32x4*)(Z + (size_t)row * 1024 + col0) = w; }
        }
    }
};
__device__ __forceinline__ float bf_lo(unsigned w) { return __builtin_bit_cast(float, w << 16); }
__device__ __forceinline__ float bf_hi(unsigned w) { return __builtin_bit_cast(float, w & 0xffff0000u); }
struct EpiResid {
    static constexpr bool PERM = true, AFTER_DRAIN = false;
    const float* base32; const float* base32b; int split_pm; float* out32; bf16_t* XB; float* SS;
    __device__ __forceinline__ void operator()(const f32x4 (&acc)[2][2][4][2], const Unit& u, int wr, int wc, int fr, int fq) const {
        const int row0 = u.pm * BM + wr * 64 + fr, col0 = u.pn * BM + wc * 32 + 8 * fq;
        const float* const b32 = (u.pm < split_pm) ? base32 : base32b;
#pragma unroll
        for (int ai = 0; ai < 2; ++ai) {
            u32x4 xo[4][2];
            if (!base32) {
#pragma unroll
                for (int m = 0; m < 4; ++m)
#pragma unroll
                    for (int bj = 0; bj < 2; ++bj) xo[m][bj] = *(const u32x4*)(XB + (size_t)(row0 + ai * HALF + m * 16) * 1024 + col0 + bj * HALF);
            }
#pragma unroll
            for (int m = 0; m < 4; ++m) { const int row = row0 + ai * HALF + m * 16; const size_t off = (size_t)row * 1024 + col0; float ss = 0.f;
                f32x4 xf[2][2];
                if (base32) {
#pragma unroll
                    for (int bj = 0; bj < 2; ++bj) { xf[bj][0] = *(const f32x4*)(b32 + off + bj * HALF); xf[bj][1] = *(const f32x4*)(b32 + off + bj * HALF + 4); } }
#pragma unroll
                for (int bj = 0; bj < 2; ++bj) {
                    f32x4 x0, x1;
                    if (base32) { x0 = xf[bj][0]; x1 = xf[bj][1]; }
                    else { const u32x4 o = xo[m][bj]; x0 = (f32x4){bf_lo(o.x), bf_hi(o.x), bf_lo(o.y), bf_hi(o.y)}; x1 = (f32x4){bf_lo(o.z), bf_hi(o.z), bf_lo(o.w), bf_hi(o.w)}; }
                    x0 += acc[ai][bj][m][0]; x1 += acc[ai][bj][m][1];
                    if (out32) { *(f32x4*)(out32 + off + bj * HALF) = x0; *(f32x4*)(out32 + off + bj * HALF + 4) = x1; }
                    ss += (x0[0] * x0[0] + x0[1] * x0[1]) + (x0[2] * x0[2] + x0[3] * x0[3]) + (x1[0] * x1[0] + x1[1] * x1[1]) + (x1[2] * x1[2] + x1[3] * x1[3]);
                    u32x4 w; w.x = cvt_pk_bf16(x0[0], x0[1]); w.y = cvt_pk_bf16(x0[2], x0[3]); w.z = cvt_pk_bf16(x1[0], x1[1]); w.w = cvt_pk_bf16(x1[2], x1[3]);
                    *(u32x4*)(XB + off + bj * HALF) = w; }
                ss += __shfl_xor(ss, 16); ss += __shfl_xor(ss, 32);
                if (fq == 0) SS[(size_t)row * 16 + 4 * u.pn + wc] = ss; }
        }
    }
};
template <class Epi, class Sched, bool ALIGN_EPI = false, bool SP2 = false>
__device__ __forceinline__ void gemm_phase(PG8_LAS unsigned char* lds, const Gemm g, const Sched& S, const Epi& E) {
    int tid_ = threadIdx.x; asm volatile("" : "+v"(tid_)); const int tid = tid_, wid = __builtin_amdgcn_readfirstlane(tid >> 6), lane = tid & 63, wr = wid >> 2, wc = wid & 3, fr = lane & 15, fq = lane >> 4;
    const int K = g.K, nt = K / BK;
    unsigned voffA[2], voffB[2];
#pragma unroll
    for (int i = 0; i < 2; ++i) { int R, C; stage_rc(tid * 16 + i * 8192, R, C); const int Rb = Epi::PERM ? ((R & ~31) + perm32(R & 31)) : R;
        voffA[i] = (unsigned)(R * K + C) * 2u; voffB[i] = (unsigned)(Rb * K + C) * 2u; }
    const size_t kstep = (size_t)(BK * 2);
    const size_t hstep = (size_t)HALF * K * 2;
    const size_t tstep = 2 * hstep;
    const unsigned ldsw = (unsigned)wid * 1024u;
    const int aoff = lds_byte(wr * 64 + fr, fq * 8), boff = lds_byte(wc * 32 + fr, fq * 8);
#define PG8_SA(b, h) (((b) * 2 + (h)) * HTB)
#define PG8_SB(b, h) ((4 + (b) * 2 + (h)) * HTB)
#define PG8_STAGE(bufoff, gbase, voff) do { _Pragma("unroll") for (int _i = 0; _i < 2; ++_i) \
        __builtin_amdgcn_global_load_lds((const unsigned*)((const char*)(gbase) + (voff)[_i]), (PG8_LAS unsigned*)(lds + (bufoff) + ldsw + _i * 8192), 16, 0, 0); } while (0)
#define PG8_LDA(dst, b, h) do { _Pragma("unroll") for (int m = 0; m < 4; ++m) _Pragma("unroll") for (int k = 0; k < 2; ++k) dst[m][k] = *(const PG8_LAS bf16x8*)(lds + PG8_SA(b, h) + aoff + m * 2048 + k * 1024); } while (0)
#define PG8_LDB(dst, b, h) do { _Pragma("unroll") for (int n = 0; n < 2; ++n) _Pragma("unroll") for (int k = 0; k < 2; ++k) dst[n][k] = *(const PG8_LAS bf16x8*)(lds + PG8_SB(b, h) + boff + n * 2048 + k * 1024); } while (0)
#define PG8_MMA(ai, bj, At, Bt) do { __builtin_amdgcn_s_setprio(1); _Pragma("unroll") for (int m = 0; m < 4; ++m) _Pragma("unroll") for (int n = 0; n < 2; ++n) _Pragma("unroll") for (int k = 0; k < 2; ++k) \
        acc[ai][bj][m][n] = __builtin_amdgcn_mfma_f32_16x16x32_bf16(Bt[n][k], At[m][k], acc[ai][bj][m][n], 0, 0, 0); __builtin_amdgcn_s_setprio(0); } while (0)
#define PG8_WAIT_V(n) asm volatile("s_waitcnt vmcnt(" #n ")" ::: "memory")
#define PG8_WAIT_L(n) asm volatile("s_waitcnt lgkmcnt(" #n ")" ::: "memory")
#define PG8_BAR __builtin_amdgcn_s_barrier()
#define PG8_SCHED __builtin_amdgcn_sched_barrier(0)
    Unit cur, nxt; int ui = 0;
    if (!S.next(0, cur)) return;
    f32x4 acc[2][2][4][2];
#pragma unroll
    for (int a = 0; a < 2; ++a)
#pragma unroll
        for (int b = 0; b < 2; ++b)
#pragma unroll
            for (int m = 0; m < 4; ++m)
#pragma unroll
                for (int n = 0; n < 2; ++n) acc[a][b][m][n] = (f32x4){0.f, 0.f, 0.f, 0.f};
    bf16x8 At[4][2], B0[2][2], B1[2][2];
    const char* cA = (const char*)g.A + (size_t)cur.pm * tstep; const char* cB = (const char*)g.Bt + (size_t)cur.pn * tstep;
    S.a_ready(cur);
    if constexpr (SP2) {
        PG8_STAGE(PG8_SB(0, 0), cB, voffB); PG8_STAGE(PG8_SB(0, 1), cB + hstep, voffB); PG8_STAGE(PG8_SA(0, 0), cA, voffA); PG8_STAGE(PG8_SA(0, 1), cA + hstep, voffA);
        if (wr == 1) PG8_BAR;
        PG8_WAIT_V(2); PG8_BAR;
        PG8_STAGE(PG8_SB(1, 0), cB + kstep, voffB); PG8_STAGE(PG8_SA(1, 0), cA + kstep, voffA); PG8_STAGE(PG8_SB(1, 1), cB + hstep + kstep, voffB);
        PG8_WAIT_V(6); PG8_BAR;
    } else {
        PG8_STAGE(PG8_SB(0, 0), cB, voffB); PG8_STAGE(PG8_SA(0, 0), cA, voffA); PG8_STAGE(PG8_SB(0, 1), cB + hstep, voffB); PG8_STAGE(PG8_SA(0, 1), cA + hstep, voffA);
        if (wr == 1) PG8_BAR;
        PG8_WAIT_V(4); PG8_BAR;
        PG8_STAGE(PG8_SB(1, 0), cB + kstep, voffB); PG8_STAGE(PG8_SA(1, 0), cA + kstep, voffA); PG8_STAGE(PG8_SB(1, 1), cB + hstep + kstep, voffB);
        PG8_WAIT_V(6); PG8_BAR;
    }
    for (;;) {
        const bool has_next = S.next(ui + 1, nxt);
        const char* nA = has_next ? (const char*)g.A + (size_t)nxt.pm * tstep : cA; const char* nB = has_next ? (const char*)g.Bt + (size_t)nxt.pn * tstep : cB;
        for (int t = 0; t < nt; t += 2) {
            const bool last = (t == nt - 2);
            const char* a1 = cA + (size_t)(t + 1) * kstep;
            const char* a2 = last ? nA : cA + (size_t)(t + 2) * kstep; const char* b2 = last ? nB : cB + (size_t)(t + 2) * kstep;
            const char* a3 = a2 + kstep; const char* b3 = b2 + kstep;
            if (last && has_next) S.a_ready(nxt);
            if constexpr (SP2) {
            PG8_LDB(B0, 0, 0); PG8_LDB(B1, 0, 1); PG8_SCHED; PG8_LDA(At, 0, 0); PG8_STAGE(PG8_SA(1, 1), a1 + hstep, voffA);
            PG8_WAIT_V(8); PG8_WAIT_L(0); PG8_BAR; PG8_MMA(0, 0, At, B0); PG8_MMA(0, 1, At, B1); PG8_BAR; PG8_SCHED;
            PG8_LDA(At, 0, 1); PG8_STAGE(PG8_SB(0, 0), b2, voffB); PG8_STAGE(PG8_SB(0, 1), b2 + hstep, voffB); PG8_STAGE(PG8_SA(0, 0), a2, voffA);
            PG8_WAIT_V(8); PG8_WAIT_L(0); PG8_BAR; PG8_MMA(1, 0, At, B0); PG8_MMA(1, 1, At, B1); PG8_BAR; PG8_SCHED;
            PG8_LDB(B0, 1, 0); PG8_LDB(B1, 1, 1); PG8_SCHED; PG8_LDA(At, 1, 0); PG8_STAGE(PG8_SA(0, 1), a2 + hstep, voffA);
            PG8_WAIT_V(8); PG8_WAIT_L(0); PG8_BAR; PG8_MMA(0, 0, At, B0); PG8_MMA(0, 1, At, B1); PG8_BAR; PG8_SCHED;
            PG8_LDA(At, 1, 1); PG8_STAGE(PG8_SB(1, 0), b3, voffB); PG8_STAGE(PG8_SB(1, 1), b3 + hstep, voffB); PG8_STAGE(PG8_SA(1, 0), a3, voffA);
            PG8_WAIT_V(8); PG8_WAIT_L(0); PG8_BAR; PG8_MMA(1, 0, At, B0); PG8_MMA(1, 1, At, B1); PG8_BAR; PG8_SCHED;
            } else {
            PG8_LDB(B0, 0, 0); PG8_SCHED; PG8_LDA(At, 0, 0); PG8_STAGE(PG8_SA(1, 1), a1 + hstep, voffA);
            PG8_WAIT_L(8); PG8_BAR; PG8_WAIT_L(0); PG8_MMA(0, 0, At, B0); PG8_BAR; PG8_SCHED;
            PG8_LDB(B1, 0, 1); PG8_STAGE(PG8_SB(0, 0), b2, voffB);
            PG8_BAR; PG8_WAIT_L(0); PG8_MMA(0, 1, At, B1); PG8_BAR;
            PG8_LDA(At, 0, 1); PG8_STAGE(PG8_SA(0, 0), a2, voffA);
            PG8_BAR; PG8_WAIT_L(0); PG8_MMA(1, 0, At, B0); PG8_BAR; PG8_SCHED;
            PG8_STAGE(PG8_SB(0, 1), b2 + hstep, voffB);
            PG8_WAIT_V(6); PG8_BAR; PG8_MMA(1, 1, At, B1); PG8_BAR;
            PG8_LDB(B0, 1, 0); PG8_SCHED; PG8_LDA(At, 1, 0); PG8_STAGE(PG8_SA(0, 1), a2 + hstep, voffA);
            PG8_WAIT_L(8); PG8_BAR; PG8_WAIT_L(0); PG8_MMA(0, 0, At, B0); PG8_BAR; PG8_SCHED;
            PG8_LDB(B1, 1, 1); PG8_STAGE(PG8_SB(1, 0), b3, voffB);
            PG8_BAR; PG8_WAIT_L(0); PG8_MMA(0, 1, At, B1); PG8_BAR;
            PG8_LDA(At, 1, 1); PG8_STAGE(PG8_SA(1, 0), a3, voffA);
            PG8_BAR; PG8_WAIT_L(0); PG8_MMA(1, 0, At, B0); PG8_BAR; PG8_SCHED;
            PG8_STAGE(PG8_SB(1, 1), b3 + hstep, voffB);
            PG8_WAIT_V(6); PG8_BAR; PG8_MMA(1, 1, At, B1); PG8_BAR;
            }
        }
        if constexpr (ALIGN_EPI) { if (wr == 0) PG8_BAR; }
        if constexpr (!Epi::AFTER_DRAIN) { E(acc, cur, wr, wc, fr, fq); S.done(cur); }
        if (!has_next) break;
#pragma unroll
        for (int a = 0; a < 2; ++a)
#pragma unroll
            for (int b = 0; b < 2; ++b)
#pragma unroll
                for (int m = 0; m < 4; ++m)
#pragma unroll
                    for (int n = 0; n < 2; ++n) acc[a][b][m][n] = (f32x4){0.f, 0.f, 0.f, 0.f};
        cur = nxt; cA = nA; cB = nB; ++ui;
        if constexpr (ALIGN_EPI) { if (wr == 1) PG8_BAR; }
    }
    PG8_WAIT_V(0);
    if constexpr (!ALIGN_EPI) { if (wr == 0) PG8_BAR; }
    PG8_BAR;
    if constexpr (Epi::AFTER_DRAIN) { E.fused(acc, cur, wr, wc, fr, fq, lds, wid, lane); S.done(cur); }
#undef PG8_SA
#undef PG8_SB
#undef PG8_STAGE
#undef PG8_LDA
#undef PG8_LDB
#undef PG8_MMA
#undef PG8_WAIT_V
#undef PG8_WAIT_L
#undef PG8_BAR
#undef PG8_SCHED
}
}
#define LAS __attribute__((address_space(3)))
typedef unsigned short bf16;
typedef unsigned v4u __attribute__((ext_vector_type(4)));
typedef unsigned v2u __attribute__((ext_vector_type(2)));
typedef float f32x4 __attribute__((ext_vector_type(4)));
constexpr int NWAVES = 8, NTHR = 512;
constexpr int D = 1024, DFF = 2816, EIN = 4096, CIN = 3072, T_ALL = 49152;
constexpr int LDS_BYTES = 150528;
constexpr size_t MiB = 1u << 20;
constexpr size_t WS_WEIN = 1 * MiB;
constexpr size_t WS_WEOUT = WS_WEIN + 16 * MiB;
constexpr size_t WS_WCIN = WS_WEOUT + 4 * MiB;
constexpr size_t WS_WCOUT = WS_WCIN + 12 * MiB;
constexpr size_t WS_WFIN = WS_WCOUT + 4 * MiB;
constexpr size_t WS_WFOUT = WS_WFIN + 44 * MiB;
constexpr size_t WS_SS = WS_WFOUT + 22 * MiB;
constexpr size_t WS_DEC = WS_SS + 4 * MiB;
constexpr size_t WS_XB = WS_DEC + 2 * MiB;
constexpr size_t WS_END_A = WS_XB + (size_t)49152 * 1024 * 2 * 6, WS_END_B = WS_XB + (size_t)32768 * 1024 * 2 * 6;
static_assert(WS_END_A <= 768 * MiB && WS_END_B <= 512 * MiB, "ws map");

struct Params {
    const float *x_prompt, *x_sample, *norm_mix, *norm_ffn, *norm_final, *even_w_in, *even_w_out, *lb_logits, *hgrn_norm, *na_rpb, *conv_w_in, *conv_w, *conv_w_out, *ffn_w_in, *ffn_w_out;
    float* out; unsigned char* ws; int ph_lo, ph_hi, mode, pad;
};

typedef __bf16 bf16x2_t __attribute__((ext_vector_type(2)));
typedef float f32x2_t __attribute__((ext_vector_type(2)));
__device__ __forceinline__ unsigned pk2(float lo, float hi) { const f32x2_t v = {lo, hi}; return __builtin_bit_cast(unsigned, __builtin_convertvector(v, bf16x2_t)); }
__device__ __forceinline__ unsigned f2bf(float f) { return pk2(f, 0.f) & 0xffffu; }
__device__ __forceinline__ float bf2f(unsigned short b) { return __builtin_bit_cast(float, (unsigned)b << 16); }
__device__ __forceinline__ float bflo(unsigned w) { return __builtin_bit_cast(float, w << 16); }
__device__ __forceinline__ float bfhi(unsigned w) { return __builtin_bit_cast(float, w & 0xffff0000u); }
__device__ __forceinline__ float wave_sum(float v) {
#pragma unroll
    for (int o = 1; o < 64; o <<= 1) v += __shfl_xor(v, o);
    return v;
}

__device__ __forceinline__ int map_col(int type, int n) {
    if (type == 1) { return n < DFF ? 256 * (n >> 7) + (n & 127) : 256 * ((n - DFF) >> 7) + 128 + ((n - DFF) & 127); }
    if (type == 2) { if (n < 1024) return n; if (n < 2048) return 1024 + 256 * ((n - 1024) >> 7) + ((n - 1024) & 127); return 1024 + 256 * ((n - 2048) >> 7) + 128 + ((n - 2048) & 127); }
    return n;
}
__device__ __forceinline__ void transpose_item(const float* W, int K, int N, bf16* WT, int type, LAS float* scr, int item, int lane, const float* g = nullptr) {
    const int nblk = N / 32, kb = item / nblk, nb = item % nblk, k0 = 64 * kb, n0 = 32 * nb;
    float wv[32];
#pragma unroll
    for (int i = 0; i < 32; ++i) wv[i] = W[(size_t)(k0 + 2 * i + (lane >> 5)) * N + n0 + (lane & 31)];
    if (g) { float gv[32];
#pragma unroll
        for (int i = 0; i < 32; ++i) gv[i] = g[k0 + 2 * i + (lane >> 5)];
#pragma unroll
        for (int i = 0; i < 32; ++i) wv[i] *= gv[i]; }
#pragma unroll
    for (int i = 0; i < 32; ++i) scr[(2 * i + (lane >> 5)) * 33 + (lane & 31)] = wv[i];
    asm volatile("s_waitcnt lgkmcnt(0)" ::: "memory");
    const int c = lane & 7; const int r0 = map_col(type, n0);
#pragma unroll
    for (int j = 0; j < 4; ++j) { const int n = (lane >> 3) + 8 * j; const LAS float* s = scr + (8 * c) * 33 + n;
        v4u o; o.x = pk2(s[0 * 33], s[1 * 33]); o.y = pk2(s[2 * 33], s[3 * 33]); o.z = pk2(s[4 * 33], s[5 * 33]); o.w = pk2(s[6 * 33], s[7 * 33]);
        *(v4u*)(WT + (size_t)(r0 + n) * K + k0 + 8 * c) = o; }
    asm volatile("s_waitcnt lgkmcnt(0)" ::: "memory");
}
__device__ __forceinline__ void convert_weights(const Params& p, LAS unsigned char* lds, int wave, int lane) {
    LAS float* scr = (LAS float*)(lds + wave * 16384);
    const int gw = blockIdx.x * NWAVES + wave, NGW = gridDim.x * NWAVES;
    constexpr int I_EI = 16 * 128, I_EO = 16 * 32, I_CI = 16 * 96, I_CO = 16 * 32, I_FI = 16 * 176, I_FO = 44 * 32;
    constexpr int NITEMS = 2 * (I_EI + I_EO + I_CI + I_CO) + 4 * (I_FI + I_FO);
    bf16* ws = (bf16*)p.ws;
    for (int it = gw; it < NITEMS; it += NGW) {
        int r = it;
        if (r < 2 * I_EI) { const int e = r / I_EI; transpose_item(p.even_w_in + (size_t)e * D * EIN, D, EIN, (bf16*)(p.ws + WS_WEIN) + (size_t)e * EIN * D, 0, scr, r % I_EI, lane, p.norm_mix + (2 * e) * D); continue; } r -= 2 * I_EI;
        if (r < 2 * I_EO) { const int e = r / I_EO; transpose_item(p.even_w_out + (size_t)e * D * D, D, D, (bf16*)(p.ws + WS_WEOUT) + (size_t)e * D * D, 0, scr, r % I_EO, lane); continue; } r -= 2 * I_EO;
        if (r < 2 * I_CI) { const int e = r / I_CI; transpose_item(p.conv_w_in + (size_t)e * D * CIN, D, CIN, (bf16*)(p.ws + WS_WCIN) + (size_t)e * CIN * D, 2, scr, r % I_CI, lane, p.norm_mix + (2 * e + 1) * D); continue; } r -= 2 * I_CI;
        if (r < 2 * I_CO) { const int e = r / I_CO; transpose_item(p.conv_w_out + (size_t)e * D * D, D, D, (bf16*)(p.ws + WS_WCOUT) + (size_t)e * D * D, 0, scr, r % I_CO, lane); continue; } r -= 2 * I_CO;
        if (r < 4 * I_FI) { const int e = r / I_FI; transpose_item(p.ffn_w_in + (size_t)e * D * 2 * DFF, D, 2 * DFF, (bf16*)(p.ws + WS_WFIN) + (size_t)e * 2 * DFF * D, 1, scr, r % I_FI, lane, p.norm_ffn + e * D); continue; } r -= 4 * I_FI;
        { const int e = r / I_FO; transpose_item(p.ffn_w_out + (size_t)e * DFF * D, DFF, D, (bf16*)(p.ws + WS_WFOUT) + (size_t)e * D * DFF, 0, scr, r % I_FO, lane); }
    }
    (void)ws;
}
__device__ __forceinline__ void px_phase(const float* x, bf16* XB, float* SS, int M, int wave, int lane) {
    const int gw = blockIdx.x * NWAVES + wave, NGW = gridDim.x * NWAVES;
    for (int m0 = gw; m0 < M; m0 += 2 * NGW) {
        const int m1 = m0 + NGW; const bool two = m1 < M;
        const f32x4* xa = (const f32x4*)(x + (size_t)m0 * D) + lane; const f32x4* xb = (const f32x4*)(x + (size_t)(two ? m1 : m0) * D) + lane;
        f32x4 va[4], vb[4]; float sa = 0.f, sb = 0.f;
#pragma unroll
        for (int j = 0; j < 4; ++j) { va[j] = xa[64 * j]; vb[j] = xb[64 * j]; }
#pragma unroll
        for (int j = 0; j < 4; ++j) { sa += (va[j][0] * va[j][0] + va[j][1] * va[j][1]) + (va[j][2] * va[j][2] + va[j][3] * va[j][3]); sb += (vb[j][0] * vb[j][0] + vb[j][1] * vb[j][1]) + (vb[j][2] * vb[j][2] + vb[j][3] * vb[j][3]); }
        sa = wave_sum(sa); sb = wave_sum(sb);
        v2u* oa = (v2u*)(XB + (size_t)m0 * D) + lane;
#pragma unroll
        for (int j = 0; j < 4; ++j) { v2u w; w.x = pk2(va[j][0], va[j][1]); w.y = pk2(va[j][2], va[j][3]); oa[64 * j] = w; }
        if (lane < 16) SS[(size_t)m0 * 16 + lane] = (lane == 0) ? sa : 0.f;
        if (two) { v2u* ob = (v2u*)(XB + (size_t)m1 * D) + lane;
#pragma unroll
            for (int j = 0; j < 4; ++j) { v2u w; w.x = pk2(vb[j][0], vb[j][1]); w.y = pk2(vb[j][2], vb[j][3]); ob[64 * j] = w; }
            if (lane < 16) SS[(size_t)m1 * 16 + lane] = (lane == 0) ? sb : 0.f; }
    }
}
__device__ __forceinline__ void final_norm(const bf16* XB, float* out, const float* g, const float* SS, int M, int wave, int lane) {
    const int gw = blockIdx.x * NWAVES + wave, NGW = gridDim.x * NWAVES;
    f32x4 ga = ((const f32x4*)g)[2 * lane], gb = ((const f32x4*)g)[2 * lane + 1], gc = ((const f32x4*)g)[128 + 2 * lane], gd = ((const f32x4*)g)[128 + 2 * lane + 1];
    for (int m0 = gw; m0 < M; m0 += 2 * NGW) {
        const int m1 = m0 + NGW; const bool two = m1 < M; const int mb = two ? m1 : m0;
        const v4u* xa = (const v4u*)(XB + (size_t)m0 * D) + lane; const v4u* xb = (const v4u*)(XB + (size_t)mb * D) + lane;
        const v4u a0 = xa[0], a1 = xa[64], b0 = xb[0], b1 = xb[64];
        const float rsa = pg8::row_rs(SS, m0), rsb = pg8::row_rs(SS, mb);
        f32x4* oa = (f32x4*)(out + (size_t)m0 * D) + 2 * lane;
        oa[0] = (f32x4){bflo(a0.x), bfhi(a0.x), bflo(a0.y), bfhi(a0.y)} * rsa * ga; oa[1] = (f32x4){bflo(a0.z), bfhi(a0.z), bflo(a0.w), bfhi(a0.w)} * rsa * gb;
        oa[128] = (f32x4){bflo(a1.x), bfhi(a1.x), bflo(a1.y), bfhi(a1.y)} * rsa * gc; oa[129] = (f32x4){bflo(a1.z), bfhi(a1.z), bflo(a1.w), bfhi(a1.w)} * rsa * gd;
        if (two) { f32x4* ob = (f32x4*)(out + (size_t)m1 * D) + 2 * lane;
            ob[0] = (f32x4){bflo(b0.x), bfhi(b0.x), bflo(b0.y), bfhi(b0.y)} * rsb * ga; ob[1] = (f32x4){bflo(b0.z), bfhi(b0.z), bflo(b0.w), bfhi(b0.w)} * rsb * gb;
            ob[128] = (f32x4){bflo(b1.x), bfhi(b1.x), bflo(b1.y), bfhi(b1.y)} * rsb * gc; ob[129] = (f32x4){bflo(b1.z), bfhi(b1.z), bflo(b1.w), bfhi(b1.w)} * rsb * gd; }
    }
}
__device__ __forceinline__ void conv_phase(const bf16* Bg, const bf16* Z, const float* cw, bf16* MIX, int M, int L) {
    constexpr int CB = 4;
    int tid_ = threadIdx.x; asm volatile("" : "+v"(tid_));
    const size_t n = (size_t)M * (D / 8), stride = (size_t)gridDim.x * NTHR;
    const size_t start = (size_t)blockIdx.x * NTHR + tid_;
    const int c8 = (int)(start & 127) * 8;
    float w0[8], w1[8], w2[8];
#pragma unroll
    for (int x = 0; x < 8; ++x) { w0[x] = cw[c8 + x]; w1[x] = cw[D + c8 + x]; w2[x] = cw[2 * D + c8 + x]; }
    for (size_t idx = start; idx < n; idx += CB * stride) {
        v4u zc[CB], bg[CB], zm[CB], zp[CB]; bool ok[CB];
#pragma unroll
        for (int u = 0; u < CB; ++u) { const size_t id = idx + u * stride; ok[u] = id < n; const int t = ok[u] ? (int)(id >> 7) : 0; const int tl = t % L;
            zc[u] = *(const v4u*)(Z + (size_t)t * D + c8); bg[u] = *(const v4u*)(Bg + (size_t)t * D + c8);
            zm[u] = *(const v4u*)(Z + (size_t)(tl > 0 ? t - 1 : t) * D + c8); zp[u] = *(const v4u*)(Z + (size_t)(tl < L - 1 ? t + 1 : t) * D + c8);
            if (tl == 0) zm[u] = (v4u){0u, 0u, 0u, 0u};
            if (tl == L - 1) zp[u] = (v4u){0u, 0u, 0u, 0u}; }
#pragma unroll
        for (int u = 0; u < CB; ++u) { if (!ok[u]) continue; const int t = (int)((idx + u * stride) >> 7);
            v4u o;
#pragma unroll
            for (int q = 0; q < 4; ++q) {
                const float y0 = bflo(bg[u][q]) * (w0[2 * q] * bflo(zm[u][q]) + w1[2 * q] * bflo(zc[u][q]) + w2[2 * q] * bflo(zp[u][q]));
                const float y1 = bfhi(bg[u][q]) * (w0[2 * q + 1] * bfhi(zm[u][q]) + w1[2 * q + 1] * bfhi(zc[u][q]) + w2[2 * q + 1] * bfhi(zp[u][q]));
                o[q] = pk2(y0, y1); }
            *(v4u*)(MIX + (size_t)t * D + c8) = o; }
    }
}
#define XB_TMO      128
#define XB_XCNT(j)  (256  + 64 * (j))
#define XB_XSUB(j)  (1280 + 64 * (j))
#define XB_XGEN(j)  (2304 + 64 * (j))
#define XB_TOP      3328
#define XB_TOPGEN   3392
#define XCD_BAR_WORDS 3456
#define XB_SPIN_CAP (1u << 18)

__device__ __forceinline__ unsigned xb_ld(unsigned* p)              { return __hip_atomic_load(p, __ATOMIC_RELAXED, __HIP_MEMORY_SCOPE_AGENT); }
__device__ __forceinline__ unsigned xb_add(unsigned* p, unsigned v) { return __hip_atomic_fetch_add(p, v, __ATOMIC_RELAXED, __HIP_MEMORY_SCOPE_AGENT); }
__device__ __forceinline__ unsigned xb_xcc_id() { return (unsigned)__builtin_amdgcn_s_getreg((3 << 11) | 20) & 0xFu; }
#define XB_SPIN(cond, bar) do { unsigned _sp = 0; while (cond) { __builtin_amdgcn_s_sleep(1); \
    if ((++_sp & 255u) == 0u) { if (xb_ld(&(bar)[XB_TMO])) break; if (_sp > XB_SPIN_CAP) { atomicAdd(&(bar)[XB_TMO], 1u); break; } } } } while (0)

struct XcdBarrier {
    unsigned* bar; unsigned x;
    volatile LAS unsigned* st;
};

__device__ __forceinline__ XcdBarrier xcd_barrier_post(unsigned* bar, volatile LAS unsigned* st) {
    XcdBarrier b; b.bar = bar; b.x = xb_xcc_id(); b.st = st;
    if (threadIdx.x == 0) { const unsigned rank = xb_add(&bar[XB_XCNT(b.x)], 1u); st[2] = rank; st[3] = b.x; }
    return b;
}
__device__ __forceinline__ void xcd_barrier_complete(unsigned* bar, unsigned x, unsigned& nloc, unsigned& nx) {
    const unsigned G = gridDim.x * gridDim.y * gridDim.z;
    unsigned sum, cnt, mine, sp = 0u;
    for (;;) {
        sum = 0u; cnt = 0u; mine = 0u;
#pragma unroll
        for (unsigned j = 0; j < 16; ++j) { const unsigned c = xb_ld(&bar[XB_XCNT(j)]); sum += c; cnt += (c > 0u) ? 1u : 0u; mine = (j == x) ? c : mine; }
        if (sum == G) break;
        __builtin_amdgcn_s_sleep(1);
        if ((++sp & 255u) == 0u) { if (xb_ld(&bar[XB_TMO])) break; if (sp > XB_SPIN_CAP) { atomicAdd(&bar[XB_TMO], 1u); break; } }
    }
    nloc = mine > 0u ? mine : 1u; nx = cnt > 0u ? cnt : 1u;
}

__device__ __forceinline__ void xcd_barrier(const XcdBarrier& b) {
    asm volatile("s_waitcnt vmcnt(0)" ::: "memory");
    __syncthreads();
    if (threadIdx.x == 0) {
        unsigned* bar = b.bar;
        __builtin_amdgcn_s_waitcnt(0);
        unsigned nloc = b.st[0], nx = b.st[1];
        if (nloc == 0u) { xcd_barrier_complete(bar, b.x, nloc, nx); b.st[0] = nloc; b.st[1] = nx; }
        const unsigned old = xb_add(&bar[XB_XSUB(b.x)], 1u);
        const unsigned gen = old / nloc;
        if (old + 1u == (gen + 1u) * nloc) {
            __builtin_amdgcn_fence(__ATOMIC_RELEASE, "agent");
            asm volatile("s_waitcnt vmcnt(0)" ::: "memory");
            const unsigned og = xb_add(&bar[XB_TOP], 1u);
            const unsigned tg = og / nx;
            if (og + 1u == (tg + 1u) * nx) xb_add(&bar[XB_TOPGEN], 1u);
            else XB_SPIN(xb_ld(&bar[XB_TOPGEN]) == tg, bar);
            __builtin_amdgcn_fence(__ATOMIC_ACQUIRE, "agent");
            xb_add(&bar[XB_XGEN(b.x)], 1u);
            asm volatile("s_waitcnt vmcnt(0)" ::: "memory");
        } else {
            XB_SPIN(xb_ld(&bar[XB_XGEN(b.x)]) == gen, bar);
            __builtin_amdgcn_fence(__ATOMIC_ACQUIRE, "agent");
            asm volatile("s_waitcnt vmcnt(0)" ::: "memory");
        }
    }
    __syncthreads();
}
typedef short bf16x8 __attribute__((ext_vector_type(8)));
typedef float f32x16 __attribute__((ext_vector_type(16)));
typedef float f32x2v __attribute__((ext_vector_type(2)));
constexpr int HG = 128, LSTR = 272, IMG = 128 * LSTR;
__device__ __forceinline__ bf16x8 as_bf8(v4u w) { return __builtin_bit_cast(bf16x8, w); }
__device__ __forceinline__ float ex2(float x) { return __builtin_amdgcn_exp2f(x); }
__device__ __forceinline__ float lb_of(const float* lbl, int e, int dir, int c) { if (e == 0) return 0.f; const float l0 = lbl[dir * 512 + c], l1 = lbl[(2 + dir) * 512 + c]; return 1.0f / (1.0f + __expf(l0 - l1)); }
__device__ __forceinline__ void hgrn_gate(float z, float lb, float& lf, float& k) {
    const float sg = 1.0f / (1.0f + __expf(-z)); const float f = lb + (1.0f - lb) * sg; lf = fmaxf(__logf(f), -80.f); k = (1.0f - lb) / (1.0f + __expf(z));
}
__device__ __forceinline__ void hgrn_store_vt(const bf16* pr, LAS unsigned char* VT, int i, int tq) {
#pragma unroll
    for (int m = 0; m < 4; ++m) { v4u w;
#pragma unroll
        for (int x = 0; x < 4; ++x) { const unsigned lo = pr[(size_t)(8 * m + 2 * x) * EIN + 1536], hi = pr[(size_t)(8 * m + 2 * x + 1) * EIN + 1536]; w[x] = lo | (hi << 16); }
        *(LAS v4u*)(VT + i * LSTR + (32 * tq + 8 * m) * 2) = w; }
}
__device__ __forceinline__ void hgrn_ld_chunks(const bf16* base, int tid, v4u (&w)[4]) {
#pragma unroll
    for (int m = 0; m < 4; ++m) { const int cid = tid + 512 * m; w[m] = *(const v4u*)(base + (size_t)(cid >> 4) * EIN + 8 * (cid & 15)); }
}
__device__ __forceinline__ void hgrn_st_chunks(LAS unsigned char* R, int tid, const v4u (&w)[4]) {
#pragma unroll
    for (int m = 0; m < 4; ++m) { const int cid = tid + 512 * m; *(LAS v4u*)(R + (cid >> 4) * LSTR + (cid & 15) * 16) = w[m]; }
}
__device__ __forceinline__ void hgrn_build_vt(const LAS unsigned char* R, LAS unsigned char* VT, int i, int tq) {
    unsigned raw[32];
#pragma unroll
    for (int uu = 0; uu < 32; ++uu) raw[uu] = *(const LAS unsigned short*)(R + (32 * tq + uu) * LSTR + 2 * i);
    __builtin_amdgcn_sched_barrier(0);
#pragma unroll
    for (int m = 0; m < 4; ++m) { v4u w;
#pragma unroll
        for (int x = 0; x < 4; ++x) w[x] = raw[8 * m + 2 * x] | (raw[8 * m + 2 * x + 1] << 16);
        *(LAS v4u*)(VT + i * LSTR + (32 * tq + 8 * m) * 2) = w; }
}
__device__ __forceinline__ void hgrn_pass1(const bf16* PROJ, bf16* ST, float* DEC, const float* lbl, int e, int L, LAS unsigned char* lds) {
    int tid_ = threadIdx.x; asm volatile("" : "+v"(tid_)); const int tid = tid_, lane = tid & 63, wave = __builtin_amdgcn_readfirstlane(tid >> 6), i = tid & 127, tq = tid >> 7;
    const int nseg = L / HG, nunits = 8 * nseg;
    LAS unsigned char* VT = lds + 2 * IMG; LAS unsigned char* R0 = lds + 3 * IMG; LAS float* TOT = (LAS float*)(lds + 4 * IMG);
    for (int u = blockIdx.x; u < nunits; u += gridDim.x) {
        const int h = u & 3, sgi = u >> 2, seq = sgi / nseg, seg = sgi % nseg;
        const bf16* pb = PROJ + ((size_t)seq * L + (size_t)seg * HG) * EIN + 128 * h;
        v4u cv[4], cz[2][4];
        hgrn_ld_chunks(pb + 1536, tid, cv); hgrn_ld_chunks(pb + 512, tid, cz[0]); hgrn_ld_chunks(pb + 1024, tid, cz[1]);
        hgrn_st_chunks(R0, tid, cv);
        __syncthreads();
        hgrn_build_vt(R0, VT, i, tq);
#pragma unroll
        for (int dir = 0; dir < 2; ++dir) {
            __syncthreads();
            hgrn_st_chunks(R0, tid, cz[dir]);
            __syncthreads();
            float lf[32], kk[32]; float tot = 0.f;
#pragma unroll
            for (int uu = 0; uu < 32; ++uu) kk[uu] = __builtin_bit_cast(float, (unsigned)*(const LAS unsigned short*)(R0 + (32 * tq + uu) * LSTR + 2 * i));
            __builtin_amdgcn_sched_barrier(0);
#pragma unroll
            for (int uu = 0; uu < 32; ++uu) { lf[uu] = __builtin_bit_cast(float, __builtin_bit_cast(unsigned, kk[uu]) << 16); kk[uu] = 1.0f - ex2(lf[uu]); tot += lf[uu]; }
            TOT[(dir * 4 + tq) * 128 + i] = tot;
            __syncthreads();
            float off = 0.f, dtot = 0.f;
#pragma unroll
            for (int q = 0; q < 4; ++q) { const float tv = TOT[(dir * 4 + q) * 128 + i]; dtot += tv; if (dir == 0 ? (q > tq) : (q < tq)) off += tv; }
            if (tq == 0) DEC[(size_t)(u * 2 + dir) * 128 + i] = ex2(dtot);
            if (dir == 0) { float run = off;
#pragma unroll
                for (int uu = 31; uu >= 0; --uu) { kk[uu] *= ex2(run); run += lf[uu]; } }
            else { float run = off;
#pragma unroll
                for (int uu = 0; uu < 32; ++uu) { kk[uu] *= ex2(run); run += lf[uu]; } }
            LAS unsigned char* KT = lds + dir * IMG;
#pragma unroll
            for (int m = 0; m < 4; ++m) { v4u w;
#pragma unroll
                for (int x = 0; x < 4; ++x) w[x] = pk2(kk[8 * m + 2 * x], kk[8 * m + 2 * x + 1]);
                *(LAS v4u*)(KT + i * LSTR + (32 * tq + 8 * m) * 2) = w; }
        }
        __syncthreads();
        {
            const int dir = wave >> 2, it = wave & 3, r32 = lane & 31, hh = lane >> 5;
            const LAS unsigned char* KT = lds + dir * IMG;
            f32x16 acc[4];
#pragma unroll
            for (int jt = 0; jt < 4; ++jt)
#pragma unroll
                for (int x = 0; x < 16; ++x) acc[jt][x] = 0.f;
#pragma unroll
            for (int ks = 0; ks < 8; ++ks) {
                const bf16x8 a = *(const LAS bf16x8*)(KT + (32 * it + r32) * LSTR + (16 * ks + 8 * hh) * 2);
#pragma unroll
                for (int jt = 0; jt < 4; ++jt) { const bf16x8 b = *(const LAS bf16x8*)(VT + (32 * jt + r32) * LSTR + (16 * ks + 8 * hh) * 2);
                    acc[jt] = __builtin_amdgcn_mfma_f32_32x32x16_bf16(a, b, acc[jt], 0, 0, 0); }
            }
            bf16* Sg = ST + (size_t)(u * 2 + dir) * 16384;
#pragma unroll
            for (int jt = 0; jt < 4; ++jt)
#pragma unroll
                for (int g = 0; g < 4; ++g) { v2u w; w.x = pk2(acc[jt][4 * g], acc[jt][4 * g + 1]); w.y = pk2(acc[jt][4 * g + 2], acc[jt][4 * g + 3]);
                    *(v2u*)(Sg + (32 * jt + r32) * 128 + 32 * it + 8 * g + 4 * hh) = w; }
        }
        __syncthreads();
    }
}
__device__ __forceinline__ void hgrn_scan(bf16* ST, const float* DEC, int L) {
    const int nseg = L / HG;
    for (int idx = blockIdx.x * NTHR + threadIdx.x; idx < 2 * 4 * 2 * 8192; idx += gridDim.x * NTHR) {
        const int pr = idx & 8191, dir = (idx >> 13) & 1, h = (idx >> 14) & 3, seq = idx >> 16, i0 = (2 * pr) & 127;
        float r0 = 0.f, r1 = 0.f;
        for (int s0 = 0; s0 < nseg; s0 += 32) {
            unsigned w[32]; float d0[32], d1[32];
#pragma unroll
            for (int x = 0; x < 32; ++x) { const int seg = dir ? nseg - 1 - (s0 + x) : (s0 + x); const int u = (seq * nseg + seg) * 4 + h;
                w[x] = *((const unsigned*)(ST + (size_t)(u * 2 + dir) * 16384) + pr);
                const f32x2v dv = *(const f32x2v*)(DEC + (size_t)(u * 2 + dir) * 128 + i0); d0[x] = dv.x; d1[x] = dv.y; }
#pragma unroll
            for (int x = 0; x < 32; ++x) { const int seg = dir ? nseg - 1 - (s0 + x) : (s0 + x); const int u = (seq * nseg + seg) * 4 + h;
                *((unsigned*)(ST + (size_t)(u * 2 + dir) * 16384) + pr) = pk2(r0, r1);
                r0 = d0[x] * r0 + bflo(w[x]); r1 = d1[x] * r1 + bfhi(w[x]); }
        }
    }
}
__device__ __forceinline__ f32x4 mfma16(bf16x8 a, bf16x8 b, f32x4 c) { return __builtin_amdgcn_mfma_f32_16x16x32_bf16(a, b, c, 0, 0, 0); }
__device__ __forceinline__ bf16x8 scale_frag(v4u w, const float (&sc)[8]) {
    v4u o;
#pragma unroll
    for (int x = 0; x < 4; ++x) o[x] = pk2(bflo(w[x]) * sc[2 * x], bfhi(w[x]) * sc[2 * x + 1]);
    return as_bf8(o);
}
__device__ __forceinline__ void hgrn_pass2(const bf16* PROJ, const bf16* ST, const float* lbl, const float* gain, int e, bf16* MIX, int L, LAS unsigned char* lds) {
    int tid_ = threadIdx.x; asm volatile("" : "+v"(tid_)); const int tid = tid_, lane = tid & 63, wave = __builtin_amdgcn_readfirstlane(tid >> 6), i = tid & 127, tq = tid >> 7;
    const int r16 = lane & 15, g4 = lane >> 4, I = wave;
    const int nseg = L / HG, nunits = 8 * nseg;
    LAS unsigned char* BQ = lds; LAS unsigned char* BK = lds + IMG; LAS unsigned char* VT = lds + 2 * IMG;
    LAS unsigned char* SI = lds + 3 * IMG; LAS float* FT = (LAS float*)(lds + 4 * IMG);
    LAS float* TS = (LAS float*)(lds + 2 * IMG) + wave * 1024;
    for (int u = blockIdx.x; u < nunits; u += gridDim.x) {
        const int h = u & 3, sgi = u >> 2, seq = sgi / nseg, seg = sgi % nseg;
        const size_t rowseg = (size_t)seq * L + (size_t)seg * HG;
        const bf16* pb = PROJ + rowseg * EIN + 128 * h;
        __syncthreads();
        f32x4 O[8], X[8];
#pragma unroll
        for (int x = 0; x < 8; ++x) { O[x] = (f32x4){0.f, 0.f, 0.f, 0.f}; X[x] = (f32x4){0.f, 0.f, 0.f, 0.f}; }
#pragma unroll 1
        for (int dir = 0; dir < 2; ++dir) {
            v4u sreg[4];
            {   v4u cz[4], cq[4];
                hgrn_ld_chunks(pb + 512 + 512 * dir, tid, cz); hgrn_ld_chunks(pb, tid, cq);
                const bf16* Sg = ST + (size_t)(u * 2 + dir) * 16384;
#pragma unroll
                for (int m = 0; m < 4; ++m) sreg[m] = *(const v4u*)(Sg + (size_t)(tid + 512 * m) * 8);
                hgrn_st_chunks(BK, tid, cz); hgrn_st_chunks(BQ, tid, cq); }
            __syncthreads();
#pragma unroll
            for (int m = 0; m < 4; ++m) { const int c = tid + 512 * m; *(LAS v4u*)(SI + (c >> 4) * LSTR + (c & 15) * 16) = sreg[m]; }
#pragma unroll 1
            for (int b = 0; b < 2; ++b) {
                LAS unsigned char* qp = BQ + (32 * tq + 16 * b) * LSTR + 2 * i; LAS unsigned char* kp = BK + (32 * tq + 16 * b) * LSTR + 2 * i;
                float lf[16], kk[16], qq[16];
#pragma unroll
                for (int uu = 0; uu < 16; ++uu) { lf[uu] = bf2f(*(const LAS unsigned short*)(kp + uu * LSTR)); qq[uu] = bf2f(*(const LAS unsigned short*)(qp + uu * LSTR)); }
                __builtin_amdgcn_sched_barrier(0);
#pragma unroll
                for (int uu = 0; uu < 16; ++uu) kk[uu] = 1.0f - ex2(lf[uu]);
                float run = 0.f;
                if (dir == 0) {
#pragma unroll
                    for (int t = 0; t < 16; ++t) { run += lf[t]; qq[t] *= ex2(run); }
                    FT[(2 * tq + b + 1) * 128 + i] = run; run = 0.f;
#pragma unroll
                    for (int t = 15; t >= 0; --t) { kk[t] *= ex2(run); run += lf[t]; }
                } else {
#pragma unroll
                    for (int t = 15; t >= 0; --t) { run += lf[t]; qq[t] *= ex2(run); }
                    FT[(2 * tq + b + 1) * 128 + i] = run; run = 0.f;
#pragma unroll
                    for (int t = 0; t < 16; ++t) { kk[t] *= ex2(run); run += lf[t]; }
                }
#pragma unroll
                for (int uu = 0; uu < 16; ++uu) { *(LAS unsigned short*)(qp + uu * LSTR) = (unsigned short)f2bf(qq[uu]); *(LAS unsigned short*)(kp + uu * LSTR) = (unsigned short)f2bf(kk[uu]); }
            }
            __syncthreads();
            if (tq == 0) { float run = 0.f; FT[i] = 0.f;
#pragma unroll
                for (int J = 1; J <= 8; ++J) { run += FT[J * 128 + i]; FT[J * 128 + i] = run; } }
            __syncthreads();
#pragma unroll
            for (int J = 0; J < 8; ++J) {
                if (dir == 0 ? (J <= I) : (J >= I)) {
                    const LAS float* FA = FT + (dir == 0 ? I : J) * 128; const LAS float* FB = FT + (dir == 0 ? J + 1 : I + 1) * 128;
                    const f32x2v a = *(const LAS f32x2v*)(FA + 2 * lane), b = *(const LAS f32x2v*)(FB + 2 * lane);
                    *(LAS f32x2v*)(TS + J * 128 + 2 * lane) = (f32x2v){ex2(a.x - b.x), ex2(a.y - b.y)}; } }
            bf16x8 qf[4];
#pragma unroll
            for (int ks = 0; ks < 4; ++ks) qf[ks] = *(const LAS bf16x8*)(BQ + (16 * I + r16) * LSTR + (32 * ks + 8 * g4) * 2);
#pragma unroll
            for (int J = 0; J < 8; ++J) {
                if (dir == 0 ? (J <= I) : (J >= I)) {
                    f32x4 acc = (f32x4){0.f, 0.f, 0.f, 0.f};
#pragma unroll
                    for (int ks = 0; ks < 4; ++ks) {
                        const int i0 = 32 * ks + 8 * g4;
                        const v4u kw = *(const LAS v4u*)(BK + (16 * J + r16) * LSTR + i0 * 2);
                        const f32x4 s0 = *(const LAS f32x4*)(TS + J * 128 + i0), s1 = *(const LAS f32x4*)(TS + J * 128 + i0 + 4);
                        const float sc[8] = {s0[0], s0[1], s0[2], s0[3], s1[0], s1[1], s1[2], s1[3]};
                        acc = mfma16(scale_frag(kw, sc), qf[ks], acc);
                    }
                    if (J == I) {
#pragma unroll
                        for (int r = 0; r < 4; ++r) { const int s = 4 * g4 + r; const bool keep = dir == 0 ? (s <= r16) : (s >= r16); acc[r] = keep ? acc[r] : 0.f; }
                    }
                    X[J] += acc;
                }
            }
            {
                const LAS float* FA = FT + (dir == 0 ? I : 8) * 128; const LAS float* FB = FT + (dir == 0 ? 0 : I + 1) * 128;
                bf16x8 qh[4];
#pragma unroll
                for (int ks = 0; ks < 4; ++ks) { const int i0 = 32 * ks + 8 * g4;
                    const f32x4 a0 = *(const LAS f32x4*)(FA + i0), a1 = *(const LAS f32x4*)(FA + i0 + 4), b0 = *(const LAS f32x4*)(FB + i0), b1 = *(const LAS f32x4*)(FB + i0 + 4);
                    float sc[8];
#pragma unroll
                    for (int x = 0; x < 4; ++x) { sc[x] = ex2(a0[x] - b0[x]); sc[4 + x] = ex2(a1[x] - b1[x]); }
                    qh[ks] = scale_frag(__builtin_bit_cast(v4u, qf[ks]), sc); }
#pragma unroll
                for (int dt = 0; dt < 8; ++dt)
#pragma unroll
                    for (int ks = 0; ks < 4; ++ks) { const bf16x8 bfr = *(const LAS bf16x8*)(SI + (16 * dt + r16) * LSTR + (32 * ks + 8 * g4) * 2); O[dt] = mfma16(qh[ks], bfr, O[dt]); }
            }
            __syncthreads();
        }
        { v4u cv[4]; hgrn_ld_chunks(pb + 1536, tid, cv); hgrn_st_chunks(SI, tid, cv); }
        __syncthreads();
        hgrn_build_vt(SI, VT, i, tq);
        v4u gch[4];
#pragma unroll
        for (int m = 0; m < 4; ++m) { const int cc = lane + 64 * m; gch[m] = *(const v4u*)(pb + (size_t)(16 * I + (cc >> 4)) * EIN + 2048 + 8 * (cc & 15)); }
        __syncthreads();
#pragma unroll
        for (int kp = 0; kp < 4; ++kp) {
            v4u aw; aw.x = pk2(X[2 * kp][0], X[2 * kp][1]); aw.y = pk2(X[2 * kp][2], X[2 * kp][3]); aw.z = pk2(X[2 * kp + 1][0], X[2 * kp + 1][1]); aw.w = pk2(X[2 * kp + 1][2], X[2 * kp + 1][3]);
            const bf16x8 af = as_bf8(aw);
#pragma unroll
            for (int dt = 0; dt < 8; ++dt) { const LAS unsigned char* vr = VT + (16 * dt + r16) * LSTR;
                const v2u lo = *(const LAS v2u*)(vr + (32 * kp + 4 * g4) * 2), hi = *(const LAS v2u*)(vr + (32 * kp + 16 + 4 * g4) * 2);
                v4u bw; bw.x = lo.x; bw.y = lo.y; bw.z = hi.x; bw.w = hi.y;
                O[dt] = mfma16(af, as_bf8(bw), O[dt]); }
        }
#pragma unroll
        for (int r = 0; r < 4; ++r) { float ss = 0.f;
#pragma unroll
            for (int dt = 0; dt < 8; ++dt) ss += O[dt][r] * O[dt][r];
            ss += __shfl_xor(ss, 1); ss += __shfl_xor(ss, 2); ss += __shfl_xor(ss, 4); ss += __shfl_xor(ss, 8);
            const float rs = rsqrtf(ss * (1.0f / 128.0f) + 1e-6f);
#pragma unroll
            for (int dt = 0; dt < 8; ++dt) *(LAS unsigned short*)(BQ + (16 * I + 4 * g4 + r) * LSTR + (16 * dt + r16) * 2) = (unsigned short)f2bf(O[dt][r] * rs); }
#pragma unroll
        for (int m = 0; m < 4; ++m) { const int cc = lane + 64 * m, tl = cc >> 4, c8 = cc & 15;
            const v4u ow = *(const LAS v4u*)(BQ + (16 * I + tl) * LSTR + c8 * 16);
            const f32x4 ga = *(const f32x4*)(gain + 128 * h + 8 * c8), gb = *(const f32x4*)(gain + 128 * h + 8 * c8 + 4);
            v4u yw;
#pragma unroll
            for (int x = 0; x < 4; ++x) { const float g0 = bflo(gch[m][x]), g1 = bfhi(gch[m][x]);
                const float y0 = bflo(ow[x]) * (x < 2 ? ga[2 * x] : gb[2 * x - 4]) * g0;
                const float y1 = bfhi(ow[x]) * (x < 2 ? ga[2 * x + 1] : gb[2 * x - 3]) * g1;
                yw[x] = pk2(y0, y1); }
            *(v4u*)(MIX + (rowseg + 16 * I + tl) * D + 128 * h + 8 * c8) = yw; }
    }
}
typedef short s16x4 __attribute__((ext_vector_type(4)));
__device__ __forceinline__ int clampi(int v, int lo, int hi) { return v < lo ? lo : (v > hi ? hi : v); }
template <int OFF> __device__ __forceinline__ void tr_read8(const unsigned (&a)[8], s16x4 (&r)[8]) {
    asm volatile("ds_read_b64_tr_b16 %0, %8 offset:%16\n\tds_read_b64_tr_b16 %1, %9 offset:%16\n\tds_read_b64_tr_b16 %2, %10 offset:%16\n\tds_read_b64_tr_b16 %3, %11 offset:%16\n\t"
                 "ds_read_b64_tr_b16 %4, %12 offset:%16\n\tds_read_b64_tr_b16 %5, %13 offset:%16\n\tds_read_b64_tr_b16 %6, %14 offset:%16\n\tds_read_b64_tr_b16 %7, %15 offset:%16\n\ts_waitcnt lgkmcnt(0)"
                 : "=&v"(r[0]), "=&v"(r[1]), "=&v"(r[2]), "=&v"(r[3]), "=&v"(r[4]), "=&v"(r[5]), "=&v"(r[6]), "=&v"(r[7])
                 : "v"(a[0]), "v"(a[1]), "v"(a[2]), "v"(a[3]), "v"(a[4]), "v"(a[5]), "v"(a[6]), "v"(a[7]), "i"(OFF) : "memory");
}
template <int KP> __device__ __forceinline__ void na_pv_step(const f32x4 (&X)[16], float inv, const unsigned (&ad)[8], int rs0, f32x4 (&O)[4]) {
    v4u aw; aw.x = pk2(X[2 * KP][0] * inv, X[2 * KP][1] * inv); aw.y = pk2(X[2 * KP][2] * inv, X[2 * KP][3] * inv);
    aw.z = pk2(X[2 * KP + 1][0] * inv, X[2 * KP + 1][1] * inv); aw.w = pk2(X[2 * KP + 1][2] * inv, X[2 * KP + 1][3] * inv);
    const unsigned soff = (unsigned)((rs0 + KP) & 7) * 8192u;
    unsigned b[8]; s16x4 vr[8];
#pragma unroll
    for (int x = 0; x < 8; ++x) b[x] = ad[x] + soff;
    tr_read8<0>(b, vr);
    const bf16x8 af = as_bf8(aw);
#pragma unroll
    for (int dt = 0; dt < 4; ++dt) { const bf16x8 bw = (bf16x8){vr[2 * dt][0], vr[2 * dt][1], vr[2 * dt][2], vr[2 * dt][3], vr[2 * dt + 1][0], vr[2 * dt + 1][1], vr[2 * dt + 1][2], vr[2 * dt + 1][3]};
        O[dt] = mfma16(af, bw, O[dt]); }
}
__device__ __forceinline__ void na_fast(const bf16* PROJ, const float* rpb, bf16* MIX, int L, LAS unsigned char* lds) {
    int tid_ = threadIdx.x; asm volatile("" : "+v"(tid_)); const int tid = tid_, lane = tid & 63, wave = __builtin_amdgcn_readfirstlane(tid >> 6);
    const int r16 = lane & 15, g4 = lane >> 4;
    const int rows = L / 64, nunits = 2 * rows * 4;
    LAS unsigned char* VI = lds; LAS float* RP = (LAS float*)(lds + 131072);
    const unsigned vi_base = (unsigned)(size_t)VI;
    const int j = wave & 3, hh = wave >> 2;
    const int bs = clampi(16 * j - 8, 0, 32), qc = 16 * j + r16, ws0 = clampi(qc - 8, 0, 48);
    bool val[8]; int dcv[8];
#pragma unroll
    for (int c8 = 0; c8 < 8; ++c8) { const int kc = bs + 16 * (c8 >> 2) + 4 * g4 + (c8 & 3); val[c8] = (kc >= ws0) && (kc < ws0 + 16); dcv[c8] = clampi(kc - qc, -15, 15) + 15; }
    unsigned ad[8];
    { const int q4 = r16 >> 2, p4 = r16 & 3, keyA = bs + 4 * g4 + q4, keyB = keyA + 16;
#pragma unroll
      for (int dt = 0; dt < 4; ++dt) {
          ad[2 * dt] = vi_base + hh * 65536 + keyA * 128 + (((2 * dt + (p4 >> 1)) ^ (((keyA >> 1) & 3) * 2)) * 16) + (p4 & 1) * 8;
          ad[2 * dt + 1] = vi_base + hh * 65536 + keyB * 128 + (((2 * dt + (p4 >> 1)) ^ (((keyB >> 1) & 3) * 2)) * 16) + (p4 & 1) * 8; } }
    const int RPS = rows >= 256 ? 8 : 4, nstrips = 8 * (rows / RPS);
    (void)nunits;
    for (int strip = blockIdx.x; strip < nstrips; strip += gridDim.x) {
      const int hp = strip & 3, seq = (strip >> 2) & 1, r0 = (strip >> 3) * RPS;
      const size_t seqbase = (size_t)seq * L;
      __syncthreads();
      { const int rs0 = clampi(r0 - 4, 0, rows - 8);
#pragma unroll 1
        for (int mb = 0; mb < 16; mb += 4) {
            v4u wv[4];
#pragma unroll
            for (int m = 0; m < 4; ++m) { const int cid = tid + 512 * (mb + m), c = cid & 7, h2 = (cid >> 3) & 1, key = cid >> 4;
                wv[m] = *(const v4u*)(PROJ + (seqbase + (size_t)(rs0 * 64 + key)) * EIN + 3584 + 64 * (2 * hp + h2) + 8 * c); }
#pragma unroll
            for (int m = 0; m < 4; ++m) { const int cid = tid + 512 * (mb + m), c = cid & 7, h2 = (cid >> 3) & 1, key = cid >> 4, col = key & 63, slot = (rs0 + (key >> 6)) & 7;
                *(LAS v4u*)(VI + h2 * 65536 + (slot * 64 + col) * 128 + ((c ^ (((col >> 1) & 3) * 2)) * 16)) = wv[m]; } }
        for (int x = tid; x < 930; x += NTHR) RP[x] = rpb[(2 * hp) * 465 + x]; }
      for (int r = r0; r < r0 + RPS; ++r) {
        const int rs0 = clampi(r - 4, 0, rows - 8), rs0n = clampi(r + 1 - 4, 0, rows - 8);
        const bool more = (r + 1 < r0 + RPS) && (rs0n != rs0);
        __syncthreads();
        v4u nw[2];
        if (more) {
#pragma unroll
            for (int m = 0; m < 2; ++m) { const int cid = tid + 512 * m, c = cid & 7, h2 = (cid >> 3) & 1, col = cid >> 4;
                nw[m] = *(const v4u*)(PROJ + (seqbase + (size_t)((rs0n + 7) * 64 + col)) * EIN + 3584 + 64 * (2 * hp + h2) + 8 * c); } }
        const int h = 2 * hp + hh;
        const size_t qtok = seqbase + (size_t)r * 64 + qc;
        bf16x8 qf[2];
#pragma unroll
        for (int ks = 0; ks < 2; ++ks) qf[ks] = *(const bf16x8*)(PROJ + qtok * EIN + 2560 + 64 * h + 32 * ks + 8 * g4);
        f32x4 X[16];
        {
            const bf16* kbase = PROJ + (seqbase + (size_t)(rs0 * 64 + bs + r16)) * EIN + 3072 + 64 * h + 8 * g4;
            bf16x8 k0[16], k1[16];
#pragma unroll
            for (int T = 0; T < 8; ++T) { const bf16* kp = kbase + (size_t)((T >> 1) * 64 + 16 * (T & 1)) * EIN; k0[2 * T] = *(const bf16x8*)kp; k0[2 * T + 1] = *(const bf16x8*)(kp + 32); }
#pragma unroll
            for (int T = 8; T < 16; ++T) { const bf16* kp = kbase + (size_t)((T >> 1) * 64 + 16 * (T & 1)) * EIN; k1[2 * (T - 8)] = *(const bf16x8*)kp; k1[2 * (T - 8) + 1] = *(const bf16x8*)(kp + 32); }
            __builtin_amdgcn_sched_barrier(0);
#pragma unroll
            for (int T = 0; T < 8; ++T) { f32x4 acc = (f32x4){0.f, 0.f, 0.f, 0.f}; acc = mfma16(k0[2 * T], qf[0], acc); X[T] = mfma16(k0[2 * T + 1], qf[1], acc); }
#pragma unroll
            for (int T = 8; T < 16; ++T) { f32x4 acc = (f32x4){0.f, 0.f, 0.f, 0.f}; acc = mfma16(k1[2 * (T - 8)], qf[0], acc); X[T] = mfma16(k1[2 * (T - 8) + 1], qf[1], acc); }
        }
        const LAS float* rp = RP + hh * 465 + (rs0 - r + 7) * 31;
        float mx = -1e30f;
#pragma unroll
        for (int T = 0; T < 16; ++T) { const int kr = T >> 1, half = T & 1;
#pragma unroll
            for (int rr = 0; rr < 4; ++rr) { const int c8 = half * 4 + rr;
                const float sc = X[T][rr] * 0.125f + rp[kr * 31 + dcv[c8]];
                X[T][rr] = val[c8] ? sc : -1e30f; mx = fmaxf(mx, X[T][rr]); } }
        mx = fmaxf(mx, __shfl_xor(mx, 16)); mx = fmaxf(mx, __shfl_xor(mx, 32));
        float sum = 0.f;
#pragma unroll
        for (int T = 0; T < 16; ++T)
#pragma unroll
            for (int rr = 0; rr < 4; ++rr) { const float pw = __expf(X[T][rr] - mx); X[T][rr] = pw; sum += pw; }
        sum += __shfl_xor(sum, 16); sum += __shfl_xor(sum, 32);
        const float inv = 1.0f / sum;
        f32x4 O[4];
#pragma unroll
        for (int dt = 0; dt < 4; ++dt) O[dt] = (f32x4){0.f, 0.f, 0.f, 0.f};
        na_pv_step<0>(X, inv, ad, rs0, O); na_pv_step<1>(X, inv, ad, rs0, O); na_pv_step<2>(X, inv, ad, rs0, O); na_pv_step<3>(X, inv, ad, rs0, O);
        na_pv_step<4>(X, inv, ad, rs0, O); na_pv_step<5>(X, inv, ad, rs0, O); na_pv_step<6>(X, inv, ad, rs0, O); na_pv_step<7>(X, inv, ad, rs0, O);
#pragma unroll
        for (int dt = 0; dt < 4; ++dt)
#pragma unroll
            for (int rr = 0; rr < 4; ++rr) MIX[(seqbase + (size_t)r * 64 + 16 * j + 4 * g4 + rr) * D + 512 + 64 * h + 16 * dt + r16] = (bf16)f2bf(O[dt][rr]);
        if (more) {
            __syncthreads();
#pragma unroll
            for (int m = 0; m < 2; ++m) { const int cid = tid + 512 * m, c = cid & 7, h2 = (cid >> 3) & 1, col = cid >> 4, slot = (rs0n + 7) & 7;
                *(LAS v4u*)(VI + h2 * 65536 + (slot * 64 + col) * 128 + ((c ^ (((col >> 1) & 3) * 2)) * 16)) = nw[m]; } }
      }
    }
}
template <class Epi> __device__ __forceinline__ void run_gemm(LAS unsigned char* lds, const bf16* A, const bf16* Bt, int M, int N, int K, const Epi& E, int vc) {
    pg8::Gemm g{A, Bt, M, N, K}; pg8::StaticOrder S; S.init(M, N, (int)gridDim.x, vc);
    pg8::gemm_phase<Epi, pg8::StaticOrder, true, true>(lds, g, S, E);
}
constexpr int RS_OFF = 131072, RS_SLOTS = 18;
static_assert(RS_OFF + RS_SLOTS * 1024 + 64 <= LDS_BYTES, "row-scale table");
__device__ __forceinline__ void stage_row_scales(LAS unsigned char* lds, const float* SS, int M, int N, int vc) {
    pg8::StaticOrder S; S.init(M, N, (int)gridDim.x, vc);
    LAS float* RS = (LAS float*)(lds + RS_OFF);
    const int t = threadIdx.x & 255, half = threadIdx.x >> 8;
    pg8::Unit u;
    for (int i = half; i < RS_SLOTS && S.next(i, u); i += 2) RS[i * 256 + t] = pg8::row_rs(SS, u.pm * 256 + t);
    __syncthreads();
}
#ifndef HGRN_SLOW
#define HGRN_SLOW 0
#endif
#ifndef MK_ONE_LAUNCH
#define MK_ONE_LAUNCH 1
#endif
enum { K_PX = 0, K_E1, K_E2, K_ES, K_E3, K_C1, K_C2, K_RES, K_F1, K_FN };
constexpr int PH_PER_PASS = 26;
__global__ void __launch_bounds__(NTHR, 2) fwd_kernel(Params p) {
    extern __shared__ __attribute__((aligned(16))) unsigned char lds_raw[];
    LAS unsigned char* lds = (LAS unsigned char*)lds_raw;
    cg::grid_group grid = cg::this_grid();
    volatile LAS unsigned* bst = (volatile LAS unsigned*)(lds + LDS_BYTES - 64);
    if (threadIdx.x < 8) bst[threadIdx.x] = 0u;
    __syncthreads();
    XcdBarrier bar = xcd_barrier_post((unsigned*)p.ws, bst);
    for (int ph = p.ph_lo; ph < p.ph_hi; ++ph) {
        int tid_ = threadIdx.x; asm volatile("" : "+v"(tid_)); const int tid = tid_, lane = tid & 63, wave = __builtin_amdgcn_readfirstlane(tid >> 6);
        (void)tid;
        const int mode = p.mode, g = ph / PH_PER_PASS, idx = ph % PH_PER_PASS;
        const int vc = (int)bst[4] ? (int)bst[5] : (int)blockIdx.x;
        int kind, l = 0, sub = 0;
        if (idx == 0) kind = K_PX; else if (idx == 25) kind = K_FN;
        else { const int j = idx - 1, pair = j / 12, r = j % 12;
            if (r < 7) { l = 2 * pair; kind = r == 0 ? K_E1 : r == 1 ? K_E2 : r == 2 ? K_ES : r == 3 ? K_E3 : r == 4 ? K_RES : r == 5 ? K_F1 : K_RES; sub = (r == 6); }
            else { l = 2 * pair + 1; const int r2 = r - 7; kind = r2 == 0 ? K_C1 : r2 == 1 ? K_C2 : r2 == 2 ? K_RES : r2 == 3 ? K_F1 : K_RES; sub = (r2 == 4); } }
        const int e = l >> 1;
        const int np = mode ? 2 : 1;
        const int gM = mode ? 49152 : (g ? 16384 : 32768);
        const size_t brows = mode ? 49152 : 32768;
        unsigned char* ws = p.ws;
        bf16* const XB = (bf16*)(ws + WS_XB); bf16* const MIX = XB + brows * D; bf16* const PROJ = MIX + brows * D; float* const SS = (float*)(ws + WS_SS);
#define PART(k) const int tr = mode ? (k) : g; const int Mk = tr ? 16384 : 32768, Lk = tr ? 8192 : 16384; const size_t r0 = (mode && tr) ? 32768 : 0; \
        const float* xin = tr ? p.x_sample : p.x_prompt; float* xres = p.out + (size_t)(tr ? 32768 : 0) * D; float* dec = (float*)(ws + WS_DEC) + ((mode && tr) ? 262144 : 0); (void)Mk; (void)Lk; (void)xin; (void)xres; (void)dec; (void)r0;
        switch (kind) {
        case K_PX: { if (g == 0) convert_weights(p, lds, wave, lane);
            for (int k = 0; k < np; ++k) { PART(k) px_phase(xin, XB + r0 * D, SS + r0 * 16, Mk, wave, lane); } } break;
        case K_E1: { stage_row_scales(lds, SS, gM, EIN, vc); run_gemm(lds, XB, (const bf16*)(ws + WS_WEIN) + (size_t)e * EIN * D, gM, EIN, D, pg8::EpiEven{PROJ, (const LAS float*)(lds + RS_OFF), p.lb_logits, e}, vc); } break;
        case K_E2: { for (int k = 0; k < np; ++k) { PART(k) hgrn_pass1(PROJ + r0 * EIN, (bf16*)xres, dec, p.lb_logits, e, Lk, lds); }
                     for (int k = 0; k < np; ++k) { PART(k) na_fast(PROJ + r0 * EIN, p.na_rpb + (size_t)e * 8 * 15 * 31, MIX + r0 * D, Lk, lds); } } break;
        case K_ES: { for (int k = 0; k < np; ++k) { PART(k) hgrn_scan((bf16*)xres, dec, Lk); } } break;
        case K_E3: { for (int k = 0; k < np; ++k) { PART(k) hgrn_pass2(PROJ + r0 * EIN, (const bf16*)xres, p.lb_logits, p.hgrn_norm + e * 512, e, MIX + r0 * D, Lk, lds); } } break;
        case K_C1: { stage_row_scales(lds, SS, gM, CIN, vc); run_gemm(lds, XB, (const bf16*)(ws + WS_WCIN) + (size_t)e * CIN * D, gM, CIN, D, pg8::EpiConvIn{PROJ, PROJ + (size_t)gM * D, (const LAS float*)(lds + RS_OFF)}, vc); } break;
        case K_C2: { for (int k = 0; k < np; ++k) { PART(k) conv_phase(PROJ + r0 * D, PROJ + (size_t)gM * D + r0 * D, p.conv_w + (size_t)e * 3 * D, MIX + r0 * D, Mk, Lk); } } break;
        case K_RES: {
            const bf16* A = sub ? PROJ : MIX;
            const bf16* Bt = sub ? (const bf16*)(ws + WS_WFOUT) + (size_t)l * D * DFF : ((l & 1) ? (const bf16*)(ws + WS_WCOUT) + (size_t)e * D * D : (const bf16*)(ws + WS_WEOUT) + (size_t)e * D * D);
            const int K = sub ? DFF : D;
            const bool first = (l == 0 && !sub);
            const float* ba = first ? (mode ? p.x_prompt : (g ? p.x_sample : p.x_prompt)) : nullptr;
            const float* bb = p.x_sample - (size_t)32768 * D;
            run_gemm(lds, A, Bt, gM, D, K, pg8::EpiResid{ba, bb, mode ? 128 : (1 << 30), nullptr, XB, SS}, vc); } break;
        case K_F1: { stage_row_scales(lds, SS, gM, 2 * DFF, vc); run_gemm(lds, XB, (const bf16*)(ws + WS_WFIN) + (size_t)l * 2 * DFF * D, gM, 2 * DFF, D, pg8::EpiSwiglu{PROJ, DFF, (const LAS float*)(lds + RS_OFF)}, vc); } break;
        default: { final_norm(XB, p.out + (size_t)((!mode && g) ? 32768 : 0) * D, p.norm_final, SS, gM, wave, lane); } break;
        }
#undef PART
        if (ph + 1 < p.ph_hi) { if (p.ph_lo < 0) grid.sync(); else xcd_barrier(bar); }
        if (ph == p.ph_lo) {
            if (threadIdx.x == 0) { bool ok = (gridDim.x % 8u) == 0u;
                for (unsigned j2 = 0; j2 < 16; ++j2) { const unsigned cnt = xb_ld((unsigned*)p.ws + XB_XCNT(j2)); ok = ok && (cnt == (j2 < 8 ? gridDim.x / 8u : 0u)); }
                bst[5] = bst[2] * 8u + bst[3]; bst[4] = ok ? 1u : 0u; }
            __syncthreads(); }
    }
}

extern "C" void kernel_launch(void* const* d_in, const int* in_sizes, int n_in, void* d_out, int out_size, void* d_ws, size_t ws_size, hipStream_t stream) {
    static int grid = 0, mode = 0;
    if (grid == 0) {
        if (n_in != 15 || out_size != T_ALL * D || ws_size < WS_END_B) { fprintf(stderr, "kernel_launch: unexpected shapes / workspace (%d inputs, out %d, ws %zu)\n", n_in, out_size, ws_size); grid = -1; return; }
        if (hipFuncSetAttribute((const void*)fwd_kernel, hipFuncAttributeMaxDynamicSharedMemorySize, LDS_BYTES) != hipSuccess) { fprintf(stderr, "kernel_launch: hipFuncSetAttribute failed\n"); grid = -1; return; }
        int dev = 0, cus = 0, per_cu = 0;
        (void)hipGetDevice(&dev); (void)hipDeviceGetAttribute(&cus, hipDeviceAttributeMultiprocessorCount, dev);
        (void)hipOccupancyMaxActiveBlocksPerMultiprocessor(&per_cu, (const void*)fwd_kernel, NTHR, LDS_BYTES);
        if (per_cu < 1) fprintf(stderr, "kernel_launch: occupancy query says %d blocks per CU\n", per_cu);
        (void)hipGetLastError();
        grid = cus;
        mode = (ws_size >= WS_END_A && cus >= 236) ? 1 : 0;
        if (cus < 160) { fprintf(stderr, "kernel_launch: %d CUs: the per-workgroup row-scale table holds %d GEMM units; nothing launched\n", cus, RS_SLOTS); grid = -1; return; }
    }
    if (grid < 0) return;
    Params p{};
    p.x_prompt = (const float*)d_in[0]; p.x_sample = (const float*)d_in[1]; p.norm_mix = (const float*)d_in[2]; p.norm_ffn = (const float*)d_in[3]; p.norm_final = (const float*)d_in[4];
    p.even_w_in = (const float*)d_in[5]; p.even_w_out = (const float*)d_in[6]; p.lb_logits = (const float*)d_in[7]; p.hgrn_norm = (const float*)d_in[8]; p.na_rpb = (const float*)d_in[9];
    p.conv_w_in = (const float*)d_in[10]; p.conv_w = (const float*)d_in[11]; p.conv_w_out = (const float*)d_in[12]; p.ffn_w_in = (const float*)d_in[13]; p.ffn_w_out = (const float*)d_in[14];
    p.out = (float*)d_out; p.ws = (unsigned char*)d_ws; p.mode = mode;
    (void)hipMemsetAsync(d_ws, 0, XCD_BAR_WORDS * 4, stream);
    p.ph_lo = 0; p.ph_hi = PH_PER_PASS * (mode ? 1 : 2);
    void* args[] = {&p};
    hipError_t e = hipLaunchCooperativeKernel((const void*)fwd_kernel, dim3(grid), dim3(NTHR), args, LDS_BYTES, stream);
    if (e != hipSuccess) fprintf(stderr, "cooperative launch failed: %s (grid %d)\n", hipGetErrorString(e), grid);
}
```
